# Optimizing an MI355X kernel written in HIP

```python
import jax, jax.numpy as jnp
from jax import lax
import numpy as np

D_MODEL = 1024
BATCH = 8
SEQ = 4096
DEPTH = 2

CTX_LEN = 256
GRID_W = 64
HEAD_DIM = 64
N_HEADS = 8
N_KV_HEADS = 2
GQA = N_HEADS // N_KV_HEADS
ATTN_WIDTH = N_HEADS * HEAD_DIM
KV_WIDTH = N_KV_HEADS * HEAD_DIM
WINDOW = 128
ATTN_BLOCK = 128
ATTN_SCALE = HEAD_DIM ** -0.5
ROPE_BASE = 10000.0
CONV_WIDTH = D_MODEL // 4
GM_WIDTH = D_MODEL // 4
GM_GROUPS = 4
GM_HEAD = GM_WIDTH // GM_GROUPS
CHUNK = 128
MIX_WIDTH = ATTN_WIDTH + CONV_WIDTH + GM_WIDTH
IN_WIDTH = ATTN_WIDTH + 2 * KV_WIDTH + 3 * CONV_WIDTH + 2 * GM_WIDTH
SPLIT_POINTS = (ATTN_WIDTH,
                ATTN_WIDTH + KV_WIDTH,
                ATTN_WIDTH + 2 * KV_WIDTH,
                ATTN_WIDTH + 2 * KV_WIDTH + CONV_WIDTH,
                ATTN_WIDTH + 2 * KV_WIDTH + 2 * CONV_WIDTH,
                ATTN_WIDTH + 2 * KV_WIDTH + 3 * CONV_WIDTH,
                ATTN_WIDTH + 2 * KV_WIDTH + 3 * CONV_WIDTH + GM_WIDTH)
N_GROUPS = 4
EXP_PER_GROUP = 8
N_EXPERTS = N_GROUPS * EXP_PER_GROUP
TOP_K = 2
D_EXPERT = D_MODEL // 2
MOE_BLOCK = 128
ALPHA = (2 * DEPTH) ** 0.25
BETA = (8 * DEPTH) ** -0.25
LN_EPS = 1e-6
NEG_INF = -1e30

kernel_name = 'hybrid_dit_conv_swa_gmlp_hmoe'


def layer_norm(x, g=None, b=None):
    xf = x.astype(jnp.float32)
    mu = jnp.mean(xf, axis=-1, keepdims=True)
    var = jnp.mean(jnp.square(xf - mu), axis=-1, keepdims=True)
    y = (xf - mu) * lax.rsqrt(var + LN_EPS)
    if g is not None:
        y = y * g.astype(jnp.float32) + b.astype(jnp.float32)
    return y.astype(x.dtype)


def _rope(x, pos):
    m = x.shape[-1] // 2
    freqs = ROPE_BASE ** (-jnp.arange(m, dtype=jnp.float32) / m)
    ang = pos.astype(jnp.float32)[:, None] * freqs[None, :]
    cos = jnp.cos(ang)[None, :, None, :]
    sin = jnp.sin(ang)[None, :, None, :]
    xf = x.astype(jnp.float32)
    a, b = xf[..., :m], xf[..., m:]
    return jnp.concatenate([a * cos - b * sin, b * cos + a * sin], axis=-1).astype(x.dtype)


def axial_rope(x, row, col):
    half = x.shape[-1] // 2
    return jnp.concatenate([_rope(x[..., :half], row), _rope(x[..., half:], col)], axis=-1)


def short_conv(u, w):
    up = jnp.pad(u, ((0, 0), (1, 1), (0, 0)))
    return up[:, :-2] * w[0] + up[:, 1:-1] * w[1] + up[:, 2:] * w[2]


def local_mixers(cb, cc, cx, gu, gv, conv_w, gm_ws, gm_bs):
    y_conv = cb * short_conv(cc * cx, conv_w)
    b_, l_ = gu.shape[:2]
    u = jax.nn.gelu(gu)
    v = layer_norm(jax.nn.gelu(gv)).reshape(b_, l_ // CHUNK, CHUNK, GM_GROUPS, GM_HEAD)
    s = jnp.einsum('gpq,bnqgc->bnpgc', gm_ws, v) + gm_bs.T[None, None, :, :, None]
    y_gm = u * s.reshape(b_, l_, GM_WIDTH).astype(u.dtype)
    return jnp.concatenate([y_conv, y_gm], axis=-1)


def sink_softmax(s, sink):
    col = jnp.broadcast_to(sink.astype(jnp.float32).reshape(N_KV_HEADS, GQA)[None, :, :, None, None],
                           s.shape[:-1] + (1,))
    return jax.nn.softmax(jnp.concatenate([col, s], axis=-1), axis=-1)[..., 1:]


def window_attention(q, k, v, k_ctx, v_ctx, sink):
    b_, s_ = q.shape[:2]
    nb = s_ // ATTN_BLOCK
    pad = ((0, 0), (ATTN_BLOCK, ATTN_BLOCK), (0, 0), (0, 0))
    kp, vp = jnp.pad(k, pad), jnp.pad(v, pad)
    span = 3 * ATTN_BLOCK
    rel = (jnp.arange(span)[None, :] - ATTN_BLOCK) - jnp.arange(ATTN_BLOCK)[:, None]
    band = jnp.abs(rel) <= WINDOW

    def one_block(n):
        start = n * ATTN_BLOCK
        qn = lax.dynamic_slice_in_dim(q, start, ATTN_BLOCK, axis=1).reshape(
            b_, ATTN_BLOCK, N_KV_HEADS, GQA, HEAD_DIM)
        kn = lax.dynamic_slice_in_dim(kp, start, span, axis=1)
        vn = lax.dynamic_slice_in_dim(vp, start, span, axis=1)
        kpos = start - ATTN_BLOCK + jnp.arange(span)
        valid = band & ((kpos >= 0) & (kpos < s_))[None, :]
        s_loc = jnp.einsum('bqkgd,bskd->bkgqs', qn, kn, preferred_element_type=jnp.float32) * ATTN_SCALE
        s_loc = jnp.where(valid, s_loc, NEG_INF)
        s_ctx = jnp.einsum('bqkgd,bckd->bkgqc', qn, k_ctx, preferred_element_type=jnp.float32) * ATTN_SCALE
        p = sink_softmax(jnp.concatenate([s_loc, s_ctx], axis=-1), sink).astype(v.dtype)
        o = (jnp.einsum('bkgqs,bskd->bqkgd', p[..., :span], vn)
             + jnp.einsum('bkgqc,bckd->bqkgd', p[..., span:], v_ctx))
        return o.reshape(b_, ATTN_BLOCK, ATTN_WIDTH)

    out = lax.map(one_block, jnp.arange(nb))
    return out.transpose(1, 0, 2, 3).reshape(b_, s_, ATTN_WIDTH)


def context_attention(q, k, v, sink):
    b_, c_ = q.shape[:2]
    qg = q.reshape(b_, c_, N_KV_HEADS, GQA, HEAD_DIM)
    s = jnp.einsum('bqkgd,bckd->bkgqc', qg, k, preferred_element_type=jnp.float32) * ATTN_SCALE
    p = sink_softmax(s, sink).astype(v.dtype)
    o = jnp.einsum('bkgqc,bckd->bqkgd', p, v)
    return o.reshape(b_, c_, ATTN_WIDTH)


def hier_moe(h, w_rg, b_rg, w_re, b_re, w1, w3, w2):
    n, d_ = h.shape
    hf = h.astype(jnp.float32)
    g_logit = hf @ w_rg.astype(jnp.float32) + b_rg.astype(jnp.float32)
    g_val, g_idx = lax.top_k(g_logit, 1)
    p_group = jnp.exp(g_val[:, 0] - jax.nn.logsumexp(g_logit, axis=-1))
    e_logit = (hf @ w_re.astype(jnp.float32)).reshape(n, N_GROUPS, EXP_PER_GROUP) \
        + b_re.astype(jnp.float32).reshape(N_GROUPS, EXP_PER_GROUP)
    e_logit = jnp.take_along_axis(e_logit, g_idx[:, :, None], axis=1)[:, 0]
    e_val, e_idx = lax.top_k(e_logit, TOP_K)
    gates = p_group[:, None] * jax.nn.softmax(e_val, axis=-1)
    expert = g_idx * EXP_PER_GROUP + e_idx

    a = n * TOP_K
    flat_e = expert.reshape(-1)
    flat_g = gates.reshape(-1)
    order = jnp.argsort(flat_e)
    se = flat_e[order]
    counts = jnp.bincount(flat_e, length=N_EXPERTS)
    starts = jnp.cumsum(counts) - counts
    padded = (counts + MOE_BLOCK - 1) // MOE_BLOCK * MOE_BLOCK
    pends = jnp.cumsum(padded)
    pstarts = pends - padded
    dest = pstarts[se] + jnp.arange(a) - starts[se]
    n_blocks = -(-a // MOE_BLOCK) + N_EXPERTS
    slot_tok = jnp.zeros(n_blocks * MOE_BLOCK, jnp.int32).at[dest].set((order // TOP_K).astype(jnp.int32))
    slot_gate = jnp.zeros(n_blocks * MOE_BLOCK, h.dtype).at[dest].set(flat_g[order].astype(h.dtype))
    block_e = jnp.minimum(jnp.searchsorted(pends, jnp.arange(n_blocks) * MOE_BLOCK, side='right'),
                          N_EXPERTS - 1)
    xs = h[slot_tok].reshape(n_blocks, MOE_BLOCK, d_)

    def run(args):
        xb, e = args
        return (jax.nn.silu(xb @ w1[e]) * (xb @ w3[e])) @ w2[e]

    ys = lax.map(run, (xs, block_e)).reshape(-1, d_)
    return jnp.zeros_like(h).at[slot_tok].add(ys * slot_gate[:, None])


def setup_inputs(seed: int = 0) -> dict:
    key = jax.random.key(seed)
    ks = jax.random.split(key, 23)

    def nrm(k, shape, s):
        return jax.random.normal(k, shape, jnp.float32) * s

    d = D_MODEL
    return {
        'x': nrm(ks[0], (BATCH, SEQ, d), 1.0),
        'c': nrm(ks[1], (BATCH, d), 1.0),
        'ctx': nrm(ks[2], (BATCH, CTX_LEN, d), 1.0),
        'c_ctx': nrm(ks[3], (d,), 1.0),
        'w_ada': nrm(ks[4], (DEPTH, d, 6 * d), d ** -0.5),
        'b_ada': nrm(ks[5], (DEPTH, 6 * d), 0.02),
        'w_in': nrm(ks[6], (DEPTH, d, IN_WIDTH), d ** -0.5),
        'conv_w': nrm(ks[7], (DEPTH, 3, CONV_WIDTH), 3 ** -0.5),
        'attn_sink': nrm(ks[8], (DEPTH, N_HEADS), 0.5),
        'gm_ws': nrm(ks[9], (DEPTH, GM_GROUPS, CHUNK, CHUNK), CHUNK ** -0.5),
        'gm_bs': 1.0 + nrm(ks[10], (DEPTH, GM_GROUPS, CHUNK), 0.02),
        'w_out': nrm(ks[11], (DEPTH, MIX_WIDTH, d), BETA * MIX_WIDTH ** -0.5),
        'ln1_g': 1.0 + nrm(ks[12], (DEPTH, d), 0.02),
        'ln1_b': nrm(ks[13], (DEPTH, d), 0.02),
        'w_rg': nrm(ks[14], (DEPTH, d, N_GROUPS), d ** -0.5),
        'b_rg': nrm(ks[15], (DEPTH, N_GROUPS), 0.01),
        'w_re': nrm(ks[16], (DEPTH, d, N_EXPERTS), d ** -0.5),
        'b_re': nrm(ks[17], (DEPTH, N_EXPERTS), 0.01),
        'w1': nrm(ks[18], (DEPTH, N_EXPERTS, d, D_EXPERT), d ** -0.5),
        'w3': nrm(ks[19], (DEPTH, N_EXPERTS, d, D_EXPERT), d ** -0.5),
        'w2': nrm(ks[20], (DEPTH, N_EXPERTS, D_EXPERT, d), BETA * D_EXPERT ** -0.5),
        'ln2_g': 1.0 + nrm(ks[21], (DEPTH, d), 0.02),
        'ln2_b': nrm(ks[22], (DEPTH, d), 0.02),
    }


def reference(x, c, ctx, c_ctx, w_ada, b_ada, w_in, conv_w, attn_sink, gm_ws, gm_bs, w_out,
              ln1_g, ln1_b, w_rg, b_rg, w_re, b_re, w1, w3, w2, ln2_g, ln2_b):
    b_, s_, d_ = x.shape
    c_len = ctx.shape[1]
    rows = s_ // GRID_W
    row = jnp.repeat(jnp.arange(rows), GRID_W)
    col = jnp.tile(jnp.arange(GRID_W), rows)
    c_act = jax.nn.silu(c)
    cc_act = jax.nn.silu(c_ctx)

    for l in range(DEPTH):
        last = l == DEPTH - 1
        mod_x = c_act @ w_ada[l] + b_ada[l]
        sh1, sc1, g1, sh2, sc2, g2 = jnp.split(mod_x[:, None, :], 6, axis=-1)
        n_mod = 2 if last else 6
        mod_c = (cc_act @ w_ada[l][:, :n_mod * d_] + b_ada[l][:n_mod * d_]).reshape(n_mod, d_)

        hx = x * (1 + sc1) + sh1
        hc = ctx * (1 + mod_c[1]) + mod_c[0]
        qx, kx, vx, cbx, ccx, cvx, gux, gvx = jnp.split(hx @ w_in[l], SPLIT_POINTS, axis=-1)
        qx = axial_rope(qx.reshape(b_, s_, N_HEADS, HEAD_DIM), row, col)
        kx = axial_rope(kx.reshape(b_, s_, N_KV_HEADS, HEAD_DIM), row, col)
        vx = vx.reshape(b_, s_, N_KV_HEADS, HEAD_DIM)
        if last:
            kc, vc = jnp.split(hc @ w_in[l][:, ATTN_WIDTH:ATTN_WIDTH + 2 * KV_WIDTH], 2, axis=-1)
        else:
            qc, kc, vc, cbc, ccc, cvc, guc, gvc = jnp.split(hc @ w_in[l], SPLIT_POINTS, axis=-1)
        kc = kc.reshape(b_, c_len, N_KV_HEADS, HEAD_DIM)
        vc = vc.reshape(b_, c_len, N_KV_HEADS, HEAD_DIM)

        att_x = window_attention(qx, kx, vx, kc, vc, attn_sink[l])
        o_x = jnp.concatenate(
            [att_x, local_mixers(cbx, ccx, cvx, gux, gvx, conv_w[l], gm_ws[l], gm_bs[l])], axis=-1) @ w_out[l]
        if not last:
            att_c = context_attention(qc, kc, vc, attn_sink[l])
            o_c = jnp.concatenate(
                [att_c, local_mixers(cbc, ccc, cvc, guc, gvc, conv_w[l], gm_ws[l], gm_bs[l])], axis=-1) @ w_out[l]
            ctx = layer_norm(ALPHA * ctx + mod_c[2] * o_c, ln1_g[l], ln1_b[l])
        x = layer_norm(ALPHA * x + g1 * o_x, ln1_g[l], ln1_b[l])

        hx = (x * (1 + sc2) + sh2).reshape(b_ * s_, d_)
        if last:
            tokens = hx
        else:
            hc = (ctx * (1 + mod_c[4]) + mod_c[3]).reshape(b_ * c_len, d_)
            tokens = jnp.concatenate([hx, hc], axis=0)
        y = hier_moe(tokens, w_rg[l], b_rg[l], w_re[l], b_re[l], w1[l], w3[l], w2[l])
        if not last:
            ctx = layer_norm(ALPHA * ctx + mod_c[5] * y[b_ * s_:].reshape(b_, c_len, d_), ln2_g[l], ln2_b[l])
        x = layer_norm(ALPHA * x + g2 * y[:b_ * s_].reshape(b_, s_, d_), ln2_g[l], ln2_b[l])

    return x
```

```cpp
#include <hip/hip_runtime.h>
#include <cstdio>
#include <cstdint>

#ifndef MK_N_LAUNCHES
#define MK_N_LAUNCHES 16
#endif

#define LAS __attribute__((address_space(3)))
#define GAS __attribute__((address_space(1)))
typedef unsigned short bf16_t;
typedef short bf16x8 __attribute__((ext_vector_type(8)));
typedef short s16x4 __attribute__((ext_vector_type(4)));
typedef float f32x2 __attribute__((ext_vector_type(2)));
typedef float f32x4 __attribute__((ext_vector_type(4)));
typedef float f32x16 __attribute__((ext_vector_type(16)));
typedef unsigned u32x2 __attribute__((ext_vector_type(2)));
typedef unsigned u32x4 __attribute__((ext_vector_type(4)));
typedef GAS unsigned gu32;

constexpr int D = 1024, NB = 8, SEQ = 4096, CTXL = 256, DEPTH = 2;
constexpr int NLAT = NB * SEQ, NCTX = NB * CTXL, NROW = NLAT + NCTX;
constexpr int INW = 2048, NE = 32, DE = 512;
constexpr int MAXSLOT = 77824;
constexpr float ALPHA = 1.4142135623730951f;
constexpr float LN_EPS = 1e-6f;
constexpr float LOG2E = 1.4426950408889634f;
constexpr float QSCALE = 0.125f * LOG2E;

constexpr size_t MiB = 1u << 20;
constexpr size_t WS_CTL = 0, CTL_ZERO_BYTES = 1 * MiB;
constexpr size_t WS_MOD = 1 * MiB;
constexpr size_t WS_ROPE = 1 * MiB + 512 * 1024;
constexpr size_t WS_GMW = 1 * MiB + 768 * 1024;
constexpr size_t WS_TOKINFO = 2 * MiB;
constexpr size_t WS_GATES = 3 * MiB;
constexpr size_t WS_LIST = 4 * MiB;
constexpr size_t WS_WIN = 10 * MiB;
constexpr size_t WS_WOUT = 18 * MiB;
constexpr size_t WS_W13 = 22 * MiB;
constexpr size_t WS_W2 = 86 * MiB;
constexpr size_t WS_HX = 118 * MiB;
constexpr size_t WS_XBUF = 186 * MiB;
constexpr size_t WS_PROJ = 322 * MiB;
constexpr size_t WS_MIX = 458 * MiB;
constexpr size_t WS_H = 322 * MiB;
constexpr size_t WS_Y = 398 * MiB;
constexpr size_t WS_END = 550 * MiB;
static_assert(WS_H + (size_t)MAXSLOT * DE * 2 <= WS_Y && WS_Y + (size_t)MAXSLOT * D * 2 <= WS_END, "ws map");
static_assert(WS_PROJ + (size_t)NROW * INW * 2 <= WS_MIX && WS_MIX + (size_t)NROW * D * 2 <= WS_END, "ws map");
static_assert(WS_LIST + (size_t)NE * NROW * 4 <= WS_WIN, "ws map");
constexpr int CW_BAR = 4096;
constexpr int CW_CNT = 8192;

constexpr int LDS_BYTES = 163840;
constexpr int RING_BYTES = 131072;
constexpr int L_TILE_E = 131072, L_TILE_R0 = L_TILE_E + 1280, L_TILE_J = L_TILE_R0 + 1280, L_PSTART = L_TILE_J + 1280, L_CNT = L_PSTART + 128, L_NT = L_CNT + 128;
constexpr int L_IDX = 131072 + 8192;
constexpr int L_N1 = 147456;
constexpr int MISC_OFF = LDS_BYTES - 256;

__device__ __forceinline__ unsigned f2bf(float f) { unsigned u = __builtin_bit_cast(unsigned, f); return (u + 0x7fffu + ((u >> 16) & 1u)) >> 16; }
__device__ __forceinline__ unsigned pk2(float lo, float hi) { return f2bf(lo) | (f2bf(hi) << 16); }
__device__ __forceinline__ float bf2f(unsigned short b) { return __builtin_bit_cast(float, ((unsigned)b) << 16); }
__device__ __forceinline__ float bflo(unsigned w) { return __builtin_bit_cast(float, w << 16); }
__device__ __forceinline__ float bfhi(unsigned w) { return __builtin_bit_cast(float, w & 0xffff0000u); }
__device__ __forceinline__ float wave_sum(float v) {
#pragma unroll
    for (int o = 1; o < 64; o <<= 1) v += __shfl_xor(v, o);
    return v;
}
__device__ __forceinline__ float silu_f(float x) { return x / (1.0f + __expf(-x)); }
__device__ __forceinline__ float gelu_tanh_f(float x) {
    const float z = 0.7978845608028654f * (x + 0.044715f * x * x * x);
    const float t = 1.0f - 2.0f / (1.0f + __expf(2.0f * z));
    return 0.5f * x * (1.0f + t);
}
#define LDS_WAIT() asm volatile("s_waitcnt lgkmcnt(0)" ::: "memory")
#define VM_WAIT() asm volatile("s_waitcnt vmcnt(0)" ::: "memory")

#define XB_TMO      128
#define XB_XCNT(j)  (256  + 64 * (j))
#define XB_XSUB(j)  (1280 + 64 * (j))
#define XB_XGEN(j)  (2304 + 64 * (j))
#define XB_TOP      3328
#define XB_TOPGEN   3392
#define XCD_BAR_WORDS 3456
#define XB_SPIN_CAP (1u << 18)
__device__ __forceinline__ unsigned xb_ld(unsigned* p)              { return __hip_atomic_load(p, __ATOMIC_RELAXED, __HIP_MEMORY_SCOPE_AGENT); }
__device__ __forceinline__ unsigned xb_add(unsigned* p, unsigned v) { return __hip_atomic_fetch_add(p, v, __ATOMIC_RELAXED, __HIP_MEMORY_SCOPE_AGENT); }
__device__ __forceinline__ unsigned xb_xcc_id() { return (unsigned)__builtin_amdgcn_s_getreg((3 << 11) | 20) & 0xFu; }
#define XB_SPIN(cond, bar) do { unsigned _sp = 0; while (cond) { __builtin_amdgcn_s_sleep(1); \
    if ((++_sp & 255u) == 0u) { if (xb_ld(&(bar)[XB_TMO])) break; if (_sp > XB_SPIN_CAP) { atomicAdd(&(bar)[XB_TMO], 1u); break; } } } } while (0)
struct XcdBarrier { unsigned* bar; unsigned x; volatile LAS unsigned* st; };
__device__ __forceinline__ XcdBarrier xcd_barrier_post(unsigned* bar, volatile LAS unsigned* st) {
    XcdBarrier b; b.bar = bar; b.x = xb_xcc_id(); b.st = st;
    if (threadIdx.x == 0) (void)xb_add(&bar[XB_XCNT(b.x)], 1u);
    return b;
}
__device__ __forceinline__ void xcd_barrier_complete(unsigned* bar, unsigned x, unsigned& nloc, unsigned& nx) {
    const unsigned G = gridDim.x * gridDim.y * gridDim.z;
    unsigned sum, cnt, mine, sp = 0u;
    for (;;) {
        sum = 0u; cnt = 0u; mine = 0u;
#pragma unroll
        for (unsigned j = 0; j < 16; ++j) { const unsigned c = xb_ld(&bar[XB_XCNT(j)]); sum += c; cnt += (c > 0u) ? 1u : 0u; mine = (j == x) ? c : mine; }
        if (sum == G) break;
        __builtin_amdgcn_s_sleep(1);
        if ((++sp & 255u) == 0u) { if (xb_ld(&bar[XB_TMO])) break; if (sp > XB_SPIN_CAP) { atomicAdd(&bar[XB_TMO], 1u); break; } }
    }
    nloc = mine > 0u ? mine : 1u; nx = cnt > 0u ? cnt : 1u;
}
__device__ __forceinline__ void xcd_barrier(const XcdBarrier& b) {
    asm volatile("s_waitcnt vmcnt(0)" ::: "memory");
    __syncthreads();
    if (threadIdx.x == 0) {
        unsigned* bar = b.bar;
        __builtin_amdgcn_s_waitcnt(0);
        unsigned nloc = b.st[0], nx = b.st[1];
        if (nloc == 0u) { xcd_barrier_complete(bar, b.x, nloc, nx); b.st[0] = nloc; b.st[1] = nx; }
        const unsigned old = xb_add(&bar[XB_XSUB(b.x)], 1u);
        const unsigned gen = old / nloc;
        if (old + 1u == (gen + 1u) * nloc) {
            __builtin_amdgcn_fence(__ATOMIC_RELEASE, "agent");
            asm volatile("s_waitcnt vmcnt(0)" ::: "memory");
            const unsigned og = xb_add(&bar[XB_TOP], 1u);
            const unsigned tg = og / nx;
            if (og + 1u == (tg + 1u) * nx) xb_add(&bar[XB_TOPGEN], 1u);
            else XB_SPIN(xb_ld(&bar[XB_TOPGEN]) == tg, bar);
            __builtin_amdgcn_fence(__ATOMIC_ACQUIRE, "agent");
            xb_add(&bar[XB_XGEN(b.x)], 1u);
            asm volatile("s_waitcnt vmcnt(0)" ::: "memory");
        } else {
            XB_SPIN(xb_ld(&bar[XB_XGEN(b.x)]) == gen, bar);
            __builtin_amdgcn_fence(__ATOMIC_ACQUIRE, "agent");
            asm volatile("s_waitcnt vmcnt(0)" ::: "memory");
        }
    }
    __syncthreads();
}

namespace pg8 {
constexpr int BM = 256, BK = 64, HALF = 128, HTB = HALF * BK * 2, STAGE_BYTES = 8 * HTB, NXCD = 8, WGM = 8;
__device__ __forceinline__ int lds_byte(int r, int c) { const int st = (r >> 4) * 2 + (c >> 5), rr = r & 15, cc = c & 31, ob = rr * 64 + cc * 2; return st * 1024 + (ob ^ (((ob >> 9) & 1) << 5)); }
__device__ __forceinline__ void stage_rc(int b, int& R, int& C) { const int st = b / 1024, sb = b % 1024, swz = sb ^ (((sb >> 9) & 1) << 5); R = (st >> 1) * 16 + swz / 64; C = (st & 1) * 32 + (swz % 64) / 2; }

struct Unit { int pm, pn, e, r0, slot; };
__device__ __forceinline__ void swz_tile(int wgid, int nM, int nN, int& pm, int& pn) {
    const int nwg = nM * nN;
    { const int q = nwg / NXCD, r = nwg % NXCD, xcd = wgid % NXCD, off = wgid / NXCD; wgid = (xcd < r ? xcd * (q + 1) : r * (q + 1) + (xcd - r) * q) + off; }
    const int nig = WGM * nN, gid = wgid / nig, fm = gid * WGM, gsz = (nM - fm) < WGM ? (nM - fm) : WGM;
    pm = fm + ((wgid % nig) % gsz); pn = (wgid % nig) / gsz;
}

template <class Epi, class Sched>
__device__ __forceinline__ void gemm_phase(LAS unsigned char* lds, const char* Abase, const int K, const Sched& S, const Epi& E) {
    int tid = threadIdx.x; asm volatile("" : "+v"(tid));
    const int wid = __builtin_amdgcn_readfirstlane(tid >> 6), lane = tid & 63, wr = wid >> 2, wc = wid & 3, fr = lane & 15, fq = lane >> 4;
    const int nt = K / BK;
    unsigned voffB[2];
#pragma unroll
    for (int i = 0; i < 2; ++i) { int R_, C_; stage_rc(tid * 16 + i * 8192, R_, C_); voffB[i] = (unsigned)(R_ * K + C_) * 2u; }
#define PG8_ROWOFFS(U, o00, o01, o10, o11) do { int t_ = tid; asm volatile("" : "+v"(t_)); int R0_, C0_, R1_, C1_; stage_rc(t_ * 16, R0_, C0_); stage_rc(t_ * 16 + 8192, R1_, C1_); \
        o00 = S.a_rowoff(U, R0_) + C0_ * 2; o01 = S.a_rowoff(U, R1_) + C1_ * 2; o10 = S.a_rowoff(U, HALF + R0_) + C0_ * 2; o11 = S.a_rowoff(U, HALF + R1_) + C1_ * 2; } while (0)
    const size_t kstep = (size_t)(BK * 2);
    const size_t hstep = (size_t)HALF * K * 2;
    const unsigned ldsw = (unsigned)wid * 1024u;
    const int aoff = lds_byte(wr * 64 + fr, fq * 8), boff = lds_byte(wc * 32 + fr, fq * 8);
#define PG8_SA(b, h) (((b) * 2 + (h)) * HTB)
#define PG8_SB(b, h) ((4 + (b) * 2 + (h)) * HTB)
#define PG8_STAGE_B(bufoff, gbase) do { _Pragma("unroll") for (int _i = 0; _i < 2; ++_i) \
        __builtin_amdgcn_global_load_lds((const unsigned*)((const char*)(gbase) + voffB[_i]), (LAS unsigned*)(lds + (bufoff) + ldsw + _i * 8192), 16, 0, 0); } while (0)
#define PG8_STAGE_A(bufoff, gbase, o0, o1) do { \
        __builtin_amdgcn_global_load_lds((const unsigned*)((const char*)(gbase) + (o0)), (LAS unsigned*)(lds + (bufoff) + ldsw), 16, 0, 0); \
        __builtin_amdgcn_global_load_lds((const unsigned*)((const char*)(gbase) + (o1)), (LAS unsigned*)(lds + (bufoff) + ldsw + 8192), 16, 0, 0); } while (0)
#define PG8_LDA(dst, b, h) do { _Pragma("unroll") for (int m = 0; m < 4; ++m) _Pragma("unroll") for (int k = 0; k < 2; ++k) dst[m][k] = *(const LAS bf16x8*)(lds + PG8_SA(b, h) + aoff + m * 2048 + k * 1024); } while (0)
#define PG8_LDB(dst, b, h) do { _Pragma("unroll") for (int n = 0; n < 2; ++n) _Pragma("unroll") for (int k = 0; k < 2; ++k) dst[n][k] = *(const LAS bf16x8*)(lds + PG8_SB(b, h) + boff + n * 2048 + k * 1024); } while (0)
#define PG8_MMA(ai, bj, At, Bt) do { __builtin_amdgcn_s_setprio(1); _Pragma("unroll") for (int m = 0; m < 4; ++m) _Pragma("unroll") for (int n = 0; n < 2; ++n) _Pragma("unroll") for (int k = 0; k < 2; ++k) \
        acc[ai][bj][m][n] = __builtin_amdgcn_mfma_f32_16x16x32_bf16(Bt[n][k], At[m][k], acc[ai][bj][m][n], 0, 0, 0); __builtin_amdgcn_s_setprio(0); } while (0)
#define PG8_WAIT_V(n) asm volatile("s_waitcnt vmcnt(" #n ")" ::: "memory")
#define PG8_WAIT_L(n) asm volatile("s_waitcnt lgkmcnt(" #n ")" ::: "memory")
#define PG8_BAR __builtin_amdgcn_s_barrier()
#define PG8_SCHED __builtin_amdgcn_sched_barrier(0)
    Unit cur, nxt; int ui = 0;
    if (!S.next(0, cur)) return;
    f32x4 acc[2][2][4][2];
#pragma unroll
    for (int a = 0; a < 2; ++a)
#pragma unroll
        for (int b = 0; b < 2; ++b)
#pragma unroll
            for (int m = 0; m < 4; ++m)
#pragma unroll
                for (int n = 0; n < 2; ++n) acc[a][b][m][n] = (f32x4){0.f, 0.f, 0.f, 0.f};
    bf16x8 At[4][2], B0[2][2], B1[2][2];
    unsigned c00, c01, c10, c11, n00, n01, n10, n11;
    PG8_ROWOFFS(cur, c00, c01, c10, c11);
    const char* cB = S.b_ptr(cur);
    const char* cA = Abase;
    PG8_STAGE_B(PG8_SB(0, 0), cB); PG8_STAGE_B(PG8_SB(0, 1), cB + hstep); PG8_STAGE_A(PG8_SA(0, 0), cA, c00, c01); PG8_STAGE_A(PG8_SA(0, 1), cA, c10, c11);
    if (wr == 1) PG8_BAR;
    PG8_WAIT_V(2); PG8_BAR;
    PG8_STAGE_B(PG8_SB(1, 0), cB + kstep); PG8_STAGE_A(PG8_SA(1, 0), cA + kstep, c00, c01); PG8_STAGE_B(PG8_SB(1, 1), cB + hstep + kstep);
    PG8_WAIT_V(6); PG8_BAR;
    for (;;) {
        const bool has_next = S.next(ui + 1, nxt);
        const char* nB = has_next ? S.b_ptr(nxt) : cB;
        if (has_next) { PG8_ROWOFFS(nxt, n00, n01, n10, n11); }
        else { n00 = c00; n01 = c01; n10 = c10; n11 = c11; }
        for (int t = 0; t < nt; t += 2) {
            const bool last = (t == nt - 2);
            const char* a1 = cA + (size_t)(t + 1) * kstep;
            const char* a2 = last ? cA : cA + (size_t)(t + 2) * kstep; const char* b2 = last ? nB : cB + (size_t)(t + 2) * kstep;
            const char* a3 = a2 + kstep; const char* b3 = b2 + kstep;
            const unsigned x00 = last ? n00 : c00, x01 = last ? n01 : c01, x10 = last ? n10 : c10, x11 = last ? n11 : c11;
            PG8_LDB(B0, 0, 0); PG8_LDB(B1, 0, 1); PG8_SCHED; PG8_LDA(At, 0, 0); PG8_STAGE_A(PG8_SA(1, 1), a1, c10, c11);
            PG8_WAIT_V(8); PG8_WAIT_L(0); PG8_BAR; PG8_MMA(0, 0, At, B0); PG8_MMA(0, 1, At, B1); PG8_BAR; PG8_SCHED;
            PG8_LDA(At, 0, 1); PG8_STAGE_B(PG8_SB(0, 0), b2); PG8_STAGE_B(PG8_SB(0, 1), b2 + hstep); PG8_STAGE_A(PG8_SA(0, 0), a2, x00, x01);
            PG8_WAIT_V(8); PG8_WAIT_L(0); PG8_BAR; PG8_MMA(1, 0, At, B0); PG8_MMA(1, 1, At, B1); PG8_BAR; PG8_SCHED;
            PG8_LDB(B0, 1, 0); PG8_LDB(B1, 1, 1); PG8_SCHED; PG8_LDA(At, 1, 0); PG8_STAGE_A(PG8_SA(0, 1), a2, x10, x11);
            PG8_WAIT_V(8); PG8_WAIT_L(0); PG8_BAR; PG8_MMA(0, 0, At, B0); PG8_MMA(0, 1, At, B1); PG8_BAR; PG8_SCHED;
            PG8_LDA(At, 1, 1); PG8_STAGE_B(PG8_SB(1, 0), b3); PG8_STAGE_B(PG8_SB(1, 1), b3 + hstep); PG8_STAGE_A(PG8_SA(1, 0), a3, x00, x01);
            PG8_WAIT_V(8); PG8_WAIT_L(0); PG8_BAR; PG8_MMA(1, 0, At, B0); PG8_MMA(1, 1, At, B1); PG8_BAR; PG8_SCHED;
        }
        if (wr == 0) PG8_BAR;
        E(acc, cur, wr, wc, fr, fq);
        if (!has_next) break;
#pragma unroll
        for (int a = 0; a < 2; ++a)
#pragma unroll
            for (int b = 0; b < 2; ++b)
#pragma unroll
                for (int m = 0; m < 4; ++m)
#pragma unroll
                    for (int n = 0; n < 2; ++n) acc[a][b][m][n] = (f32x4){0.f, 0.f, 0.f, 0.f};
        cur = nxt; cB = nB; c00 = n00; c01 = n01; c10 = n10; c11 = n11; ++ui;
        if (wr == 1) PG8_BAR;
    }
    PG8_WAIT_V(0);
    PG8_BAR;
#undef PG8_ROWOFFS
#undef PG8_SA
#undef PG8_SB
#undef PG8_STAGE_A
#undef PG8_STAGE_B
#undef PG8_LDA
#undef PG8_LDB
#undef PG8_MMA
#undef PG8_WAIT_V
#undef PG8_WAIT_L
#undef PG8_BAR
#undef PG8_SCHED
}
}
using pg8::Unit;

struct SchedPlain {
    int nM, nN, nX, xpm0, xpn, G, c; unsigned rowbytes; const char* Bt; size_t btile;
    __device__ __forceinline__ bool next(int i, Unit& u) const {
        const int L = i * G + c, nwg = nM * nN;
        if (L < nwg) { pg8::swz_tile(L, nM, nN, u.pm, u.pn); }
        else if (L < nwg + nX) { u.pm = xpm0 + (L - nwg); u.pn = xpn; }
        else return false;
        u.e = 0; u.r0 = u.pm * 256; u.slot = i; return true;
    }
    __device__ __forceinline__ unsigned a_rowoff(const Unit& u, int r) const { return (unsigned)(u.r0 + r) * rowbytes; }
    __device__ __forceinline__ const char* b_ptr(const Unit& u) const { return Bt + (size_t)u.pn * btile; }
};
template <bool GATHER> struct SchedMoe {
    int ntile, G, c; unsigned rowbytes; const char* Bt; size_t btile, bexp;
    LAS const int* tile_e; LAS const int* tile_r0; LAS const int* idx;
    __device__ __forceinline__ bool next(int i, Unit& u) const {
        const int L = i * G + c; if (L >= 4 * ntile) return false;
        const int t = L >> 2; u.pn = L & 3; u.pm = t; u.e = __builtin_amdgcn_readfirstlane(tile_e[t]); u.r0 = __builtin_amdgcn_readfirstlane(tile_r0[t]); u.slot = i; return true;
    }
    __device__ __forceinline__ unsigned a_rowoff(const Unit& u, int r) const {
        if (GATHER) return (unsigned)idx[u.slot * 256 + r];
        else return (unsigned)(u.r0 + r) * rowbytes;
    }
    __device__ __forceinline__ const char* b_ptr(const Unit& u) const { return Bt + (size_t)u.e * bexp + (size_t)u.pn * btile; }
};

struct EpiProj {
    bf16_t* O; const float* rope;
    __device__ __forceinline__ void operator()(const f32x4 (&acc)[2][2][4][2], const Unit& u, int wr, int wc, int fr, int fq) const {
        const int row0 = u.pm * 256 + wr * 64 + fr, col0 = u.pn * 256 + wc * 32 + 4 * fq;
        const bool lat = (u.pm * 256) < NLAT;
        const float qs = (u.pn < 2) ? QSCALE : 1.0f;
#pragma unroll
        for (int ai = 0; ai < 2; ++ai)
#pragma unroll
            for (int m = 0; m < 4; ++m) {
                const int row = row0 + ai * 128 + m * 16;
                bf16_t* rowp = O + (size_t)row * INW + col0;
                const int t = row & (SEQ - 1);
                const int pos = (wc & 1) ? (t & 63) : (t >> 6);
                f32x4 cs = (f32x4){1.f, 1.f, 1.f, 1.f}, sn = (f32x4){0.f, 0.f, 0.f, 0.f};
                if (lat && u.pn <= 2) { cs = *(const f32x4*)(rope + pos * 16 + 4 * fq); sn = *(const f32x4*)(rope + 1024 + pos * 16 + 4 * fq); }
#pragma unroll
                for (int bj = 0; bj < 2; ++bj) {
                    f32x4 a = acc[ai][bj][m][0], b = acc[ai][bj][m][1];
                    const bool rot = lat && (u.pn < 2 || (u.pn == 2 && bj == 0));
                    if (rot) { const f32x4 na = a * cs - b * sn, nb = b * cs + a * sn; a = na; b = nb; }
                    a *= qs; b *= qs;
                    u32x2 w0, w1; w0.x = pk2(a[0], a[1]); w0.y = pk2(a[2], a[3]); w1.x = pk2(b[0], b[1]); w1.y = pk2(b[2], b[3]);
                    *(u32x2*)(rowp + bj * 128) = w0; *(u32x2*)(rowp + bj * 128 + 16) = w1;
                }
            }
    }
};
struct EpiOut {
    float* xbuf; const float* src_lat; const float* src_ctx; const float* mod_l;
    __device__ __forceinline__ void operator()(const f32x4 (&acc)[2][2][4][2], const Unit& u, int wr, int wc, int fr, int fq) const {
        const int row0 = u.pm * 256 + wr * 64 + fr, col0 = u.pn * 256 + wc * 32 + 4 * fq;
        const int tr0 = u.pm * 256;
        const bool lat = tr0 < NLAT;
        const int mr = lat ? (tr0 / SEQ) : 8;
        const float* gate = mod_l + mr * 6144 + 2 * D;
        const float* src = lat ? src_lat : src_ctx;
        f32x4 gv[2][2];
#pragma unroll
        for (int bj = 0; bj < 2; ++bj)
#pragma unroll
            for (int n = 0; n < 2; ++n) gv[bj][n] = *(const f32x4*)(gate + col0 + bj * 128 + n * 16);
#pragma unroll
        for (int ai = 0; ai < 2; ++ai)
#pragma unroll
            for (int m = 0; m < 4; ++m) {
                const int row = row0 + ai * 128 + m * 16;
                const float* sp = src + (size_t)row * D + col0;
                float* dp = xbuf + (size_t)row * D + col0;
#pragma unroll
                for (int bj = 0; bj < 2; ++bj)
#pragma unroll
                    for (int n = 0; n < 2; ++n) { const f32x4 xi = *(const f32x4*)(sp + bj * 128 + n * 16); *(f32x4*)(dp + bj * 128 + n * 16) = ALPHA * xi + gv[bj][n] * acc[ai][bj][m][n]; }
            }
    }
};
struct EpiH {
    bf16_t* H;
    __device__ __forceinline__ void operator()(const f32x4 (&acc)[2][2][4][2], const Unit& u, int wr, int wc, int fr, int fq) const {
        const int row0 = u.r0 + wr * 64 + fr, col0 = u.pn * 128 + wc * 32 + 4 * fq;
#pragma unroll
        for (int ai = 0; ai < 2; ++ai)
#pragma unroll
            for (int m = 0; m < 4; ++m) {
                bf16_t* rowp = H + (size_t)(row0 + ai * 128 + m * 16) * DE + col0;
#pragma unroll
                for (int n = 0; n < 2; ++n) { const f32x4 a = acc[ai][0][m][n], b = acc[ai][1][m][n];
                    u32x2 w; w.x = pk2(silu_f(a[0]) * b[0], silu_f(a[1]) * b[1]); w.y = pk2(silu_f(a[2]) * b[2], silu_f(a[3]) * b[3]);
                    *(u32x2*)(rowp + n * 16) = w; }
            }
    }
};
struct EpiY {
    bf16_t* Y;
    __device__ __forceinline__ void operator()(const f32x4 (&acc)[2][2][4][2], const Unit& u, int wr, int wc, int fr, int fq) const {
        const int row0 = u.r0 + wr * 64 + fr, col0 = u.pn * 256 + wc * 32 + 4 * fq;
#pragma unroll
        for (int ai = 0; ai < 2; ++ai)
#pragma unroll
            for (int m = 0; m < 4; ++m) {
                bf16_t* rowp = Y + (size_t)(row0 + ai * 128 + m * 16) * D + col0;
#pragma unroll
                for (int bj = 0; bj < 2; ++bj)
#pragma unroll
                    for (int n = 0; n < 2; ++n) { const f32x4 a = acc[ai][bj][m][n]; u32x2 w; w.x = pk2(a[0], a[1]); w.y = pk2(a[2], a[3]); *(u32x2*)(rowp + bj * 128 + n * 16) = w; }
            }
    }
};

struct Args { const float* in[23]; float* out; unsigned char* ws; int ph_lo, ph_hi; };
typedef __attribute__((address_space(4))) const Args CArgs;
enum { I_X = 0, I_C, I_CTX, I_CCTX, I_WADA, I_BADA, I_WIN, I_CONVW, I_SINK, I_GMWS, I_GMBS, I_WOUT, I_LN1G, I_LN1B, I_WRG, I_BRG, I_WRE, I_BRE, I_W1, I_W3, I_W2, I_LN2G, I_LN2B };
constexpr int NPH = 16;

__device__ __forceinline__ void transpose_item(const float* W, int ldw, int k0, int n0, bf16_t* dst, int ldt, LAS float* scr, int lane) {
#pragma unroll 8
    for (int i = 0; i < 32; ++i) { const int kk = 2 * i + (lane >> 5); scr[kk * 33 + (lane & 31)] = W[(size_t)(k0 + kk) * ldw + n0 + (lane & 31)]; }
    LDS_WAIT(); asm volatile("" ::: "memory");
    const int c = lane & 7;
#pragma unroll
    for (int j = 0; j < 4; ++j) { const int n = (lane >> 3) + 8 * j; const LAS float* s = scr + (8 * c) * 33 + n;
        u32x4 o; o.x = pk2(s[0 * 33], s[1 * 33]); o.y = pk2(s[2 * 33], s[3 * 33]); o.z = pk2(s[4 * 33], s[5 * 33]); o.w = pk2(s[6 * 33], s[7 * 33]);
        *(u32x4*)(dst + (size_t)n * ldt + k0 + 8 * c) = o; }
    LDS_WAIT(); asm volatile("" ::: "memory");
}
__device__ __forceinline__ void convert_experts(const float* w1, const float* w3, const float* w2, bf16_t* W13T, bf16_t* W2T, int l, LAS float* scr, int gw, int NGW, int lane) {
    constexpr int I13 = NE * 16 * 16, I2 = NE * 8 * 32;
    for (int it = gw; it < 2 * I13 + I2; it += NGW) {
        if (it < 2 * I13) {
            const int which = it / I13, r = it % I13, e = r / 256, q = r % 256, kb = q / 16, nb = q % 16, n0 = nb * 32;
            const float* W = (which ? w3 : w1) + ((size_t)l * NE + e) * (size_t)D * DE;
            bf16_t* dst = W13T + ((size_t)e * 1024 + (n0 >> 7) * 256 + which * 128 + (n0 & 127)) * D;
            transpose_item(W, DE, kb * 64, n0, dst, D, scr, lane);
        } else {
            const int r = it - 2 * I13, e = r / 256, q = r % 256, kb = q / 32, nb = q % 32, n0 = nb * 32;
            const float* W = w2 + ((size_t)l * NE + e) * (size_t)DE * D;
            bf16_t* dst = W2T + ((size_t)e * 1024 + n0) * DE;
            transpose_item(W, D, kb * 64, n0, dst, DE, scr, lane);
        }
    }
}

__global__ void __launch_bounds__(512, 2) fwd_kernel(Args args) {
    extern __shared__ __attribute__((aligned(16))) unsigned char lds_raw[];
    LAS unsigned char* lds = (LAS unsigned char*)lds_raw;
    volatile LAS unsigned* MISC = (volatile LAS unsigned*)(lds + MISC_OFF);
    const int tid = threadIdx.x, lane = tid & 63, wave = __builtin_amdgcn_readfirstlane(tid >> 6);
    const int G = gridDim.x, bx = blockIdx.x;
    const int gw = bx * 8 + wave, NGW = G * 8;
#define KARGS() ({ CArgs* _kp = (CArgs*)__builtin_amdgcn_kernarg_segment_ptr(); asm volatile("" : "+s"(_kp)); _kp; })
#define PHASE_PTRS() CArgs* kp = KARGS(); unsigned char* const ws = kp->ws; int tid = threadIdx.x; asm volatile("" : "+v"(tid)); const int lane = tid & 63
#define ctl ((gu32*)(ws + WS_CTL))
#define modall ((float*)(ws + WS_MOD))
#define rope ((float*)(ws + WS_ROPE))
#define gmw ((bf16_t*)(ws + WS_GMW))
#define tokinfo ((int*)(ws + WS_TOKINFO))
#define gates ((float*)(ws + WS_GATES))
#define elist ((int*)(ws + WS_LIST))
#define WinT ((bf16_t*)(ws + WS_WIN))
#define WoutT ((bf16_t*)(ws + WS_WOUT))
#define W13T ((bf16_t*)(ws + WS_W13))
#define W2T ((bf16_t*)(ws + WS_W2))
#define hx ((bf16_t*)(ws + WS_HX))
#define xbuf ((float*)(ws + WS_XBUF))
#define proj ((bf16_t*)(ws + WS_PROJ))
#define mix ((bf16_t*)(ws + WS_MIX))
#define Hb ((bf16_t*)(ws + WS_H))
#define Yb ((bf16_t*)(ws + WS_Y))
#define mod_l (modall + (size_t)l * 9 * 6144)
#define cnt_l (ctl + CW_CNT + l * 64)
    CArgs* kp0 = KARGS();
    for (int u = tid; u < 64; u += 512) ((LAS unsigned*)(lds + MISC_OFF))[u] = 0u;
    __syncthreads();
    XcdBarrier bar; bar.bar = (unsigned*)(kp0->ws + WS_CTL) + CW_BAR; bar.x = 0; bar.st = nullptr;
    if (MK_N_LAUNCHES == 1) bar = xcd_barrier_post((unsigned*)(kp0->ws + WS_CTL) + CW_BAR, MISC + 8);
    const int lo = kp0->ph_lo, hi = kp0->ph_hi;
#ifndef PH_MASK
#define PH_MASK 0xFFFFFFFFu
#endif
#define IN(k) (((PH_MASK >> ((k) < 2 ? (k) : 2 + ((k) - 2) % 7)) & 1u) && lo <= (k) && (k) < hi)
#define GRID_BAR(k) do { if (IN(k) && IN((k) + 1)) xcd_barrier(bar); } while (0)

    if (IN(0)) {
            PHASE_PTRS();
        LAS float* cs = (LAS float*)(lds + 73728);
        LAS float* red = (LAS float*)(lds + 73728 + 36864);
        for (int i = tid; i < 9 * D; i += 512) { const int r = i >> 10, k = i & 1023; const float v = (r < 8) ? kp->in[I_C][r * D + k] : kp->in[I_CCTX][k]; cs[i] = silu_f(v); }
        __syncthreads();
        for (int item = bx; item < 2 * 96; item += G) {
            const int l = item / 96, n0 = (item % 96) * 64;
            const int kq = lane >> 4, cg = lane & 15;
            const float* wp = kp->in[I_WADA] + ((size_t)l * D + wave * 128 + kq) * 6144 + n0 + 4 * cg;
            f32x4 a[9];
#pragma unroll
            for (int r = 0; r < 9; ++r) a[r] = (f32x4){0.f, 0.f, 0.f, 0.f};
#pragma unroll 4
            for (int i = 0; i < 32; ++i) {
                const f32x4 w = *(const f32x4*)(wp + (size_t)(4 * i) * 6144);
                const int k = wave * 128 + 4 * i + kq;
#pragma unroll
                for (int r = 0; r < 9; ++r) a[r] += cs[r * D + k] * w;
            }
#pragma unroll
            for (int r = 0; r < 9; ++r)
#pragma unroll
                for (int j = 0; j < 4; ++j) { float v = a[r][j]; v += __shfl_xor(v, 16); v += __shfl_xor(v, 32); a[r][j] = v; }
            if (kq == 0) {
#pragma unroll
                for (int r = 0; r < 9; ++r)
#pragma unroll
                    for (int j = 0; j < 4; ++j) red[(wave * 9 + r) * 64 + 4 * cg + j] = a[r][j];
            }
            __syncthreads();
            for (int i = tid; i < 9 * 64; i += 512) {
                const int r = i >> 6, cidx = i & 63; float s = 0.f;
#pragma unroll
                for (int w = 0; w < 8; ++w) s += red[(w * 9 + r) * 64 + cidx];
                modall[((size_t)l * 9 + r) * 6144 + n0 + cidx] = s + kp->in[I_BADA][l * 6144 + n0 + cidx];
            }
            __syncthreads();
        }
        if (bx == G - 1) {
            for (int i = tid; i < 1024; i += 512) { const int pos = i >> 4, f = i & 15; const float fr_ = powf(10000.0f, -(float)f / 16.0f); const float ang = (float)pos * fr_; rope[i] = cosf(ang); rope[1024 + i] = sinf(ang); }
        }
        for (int i = bx * 512 + tid; i < 2 * 4 * 128 * 128; i += G * 512) gmw[i] = (bf16_t)f2bf(kp->in[I_GMWS][i]);
        LAS float* scr = (LAS float*)(lds + wave * 9216);
        {
            constexpr int IW = 16 * 64, IO = 16 * 32;
            for (int it = gw; it < 2 * IW + 2 * IO; it += NGW) {
                if (it < 2 * IW) { const int l = it / IW, q = it % IW, kb = q / 64, nb = q % 64;
                    transpose_item(kp->in[I_WIN] + (size_t)l * D * INW, INW, kb * 64, nb * 32, WinT + ((size_t)l * INW + nb * 32) * D, D, scr, lane); }
                else { const int r = it - 2 * IW, l = r / IO, q = r % IO, kb = q / 32, nb = q % 32;
                    transpose_item(kp->in[I_WOUT] + (size_t)l * D * D, D, kb * 64, nb * 32, WoutT + ((size_t)l * D + nb * 32) * D, D, scr, lane); }
            }
        }
        convert_experts(kp->in[I_W1], kp->in[I_W3], kp->in[I_W2], W13T, W2T, 0, scr, gw, NGW, lane);
    }
    GRID_BAR(0);

    if (IN(1)) {
            PHASE_PTRS();
        for (int r = gw; r < NROW; r += NGW) {
            const float* src = (r < NLAT) ? kp->in[I_X] + (size_t)r * D : kp->in[I_CTX] + (size_t)(r - NLAT) * D;
            const float* md = modall + (size_t)((r < NLAT) ? (r / SEQ) : 8) * 6144;
            u32x2* dst = (u32x2*)(hx + (size_t)r * D);
#pragma unroll
            for (int j = 0; j < 4; ++j) {
                const int c = 256 * j + 4 * lane;
                const f32x4 v = *(const f32x4*)(src + c), sh = *(const f32x4*)(md + c), sc = *(const f32x4*)(md + D + c);
                const f32x4 h = v * (1.0f + sc) + sh;
                u32x2 w; w.x = pk2(h[0], h[1]); w.y = pk2(h[2], h[3]); dst[64 * j + lane] = w;
            }
        }
    }
    GRID_BAR(1);

    for (int l = 0; l < DEPTH; ++l) {
        const int pb = 2 + 7 * l;
        const bool lastl = (l == DEPTH - 1);
        const int nrow_l = lastl ? NLAT : NROW;

        if (IN(pb + 0)) {
            PHASE_PTRS();
            SchedPlain S; S.nM = nrow_l / 256; S.nN = 8; S.nX = lastl ? (NCTX / 256) : 0; S.xpm0 = NLAT / 256; S.xpn = 2; S.G = G; S.c = bx;
            S.rowbytes = D * 2; S.Bt = (const char*)(WinT + (size_t)l * INW * D); S.btile = (size_t)256 * D * 2;
            EpiProj E{proj, rope};
            pg8::gemm_phase<EpiProj, SchedPlain>(lds, (const char*)hx, D, S, E);
        }
        GRID_BAR(pb + 0);

        if (IN(pb + 1)) {
            PHASE_PTRS();
            const int n_att = NB * 32 * 2 + (lastl ? 0 : NB * 2 * 2);
            const int n_loc = nrow_l / 128;
            for (int uidx = bx; uidx < n_att + n_loc; uidx += G) {
                if (uidx < n_att) {
                    int b, nb, g, qrow0;
                    if (uidx < NB * 64) { b = uidx >> 6; nb = (uidx >> 1) & 31; g = uidx & 1; qrow0 = b * SEQ + nb * 128; }
                    else { const int v = uidx - NB * 64; b = v >> 2; nb = -1; g = v & 1; qrow0 = NLAT + b * CTXL + ((v >> 1) & 1) * 128; }
                    const int r32 = lane & 31, hi_ = lane >> 5;
                    const int hh = 4 * g + (wave & 3), qs = 64 * (wave >> 2);
                    bf16x8 qf[2][4];
#pragma unroll
                    for (int qt = 0; qt < 2; ++qt)
#pragma unroll
                        for (int d0 = 0; d0 < 4; ++d0) qf[qt][d0] = *(const bf16x8*)(proj + (size_t)(qrow0 + qs + 32 * qt + r32) * INW + hh * 64 + 16 * d0 + 8 * hi_);
                    float mrun[2], lrun[2]; f32x16 o[2][2];
                    const float sink2 = kp->in[I_SINK][l * 8 + hh] * LOG2E;
#pragma unroll
                    for (int qt = 0; qt < 2; ++qt) { mrun[qt] = sink2; lrun[qt] = hi_ ? 0.f : 1.f;
#pragma unroll
                        for (int db = 0; db < 2; ++db)
#pragma unroll
                            for (int r = 0; r < 16; ++r) o[qt][db][r] = 0.f; }
                    LAS unsigned char* Kl = lds; LAS unsigned char* Vl = lds + 18432;
                    for (int c = 0; c < 5; ++c) {
                        int krow0, mtype = 0;
                        if (c < 3) { if (nb < 0) continue; const int kb = nb - 1 + c; if (kb < 0 || kb >= 32) continue; krow0 = b * SEQ + kb * 128; mtype = (c == 0) ? 1 : (c == 2 ? 2 : 0); }
                        else krow0 = NLAT + b * CTXL + (c - 3) * 128;
                        __syncthreads();
#pragma unroll
                        for (int i = 0; i < 2; ++i) { const int p = tid + 512 * i, row = p >> 3, c16 = p & 7;
                            const bf16_t* src = proj + (size_t)(krow0 + row) * INW + 512 + 64 * g + c16 * 8;
                            const u32x4 kv = *(const u32x4*)src, vv = *(const u32x4*)(src + 128);
                            *(LAS u32x4*)(Kl + row * 144 + c16 * 16) = kv; *(LAS u32x4*)(Vl + row * 144 + c16 * 16) = vv; }
                        __syncthreads();
#pragma unroll 1
                        for (int kvt = 0; kvt < 4; ++kvt) {
                            bf16x8 kf[4];
#pragma unroll
                            for (int d0 = 0; d0 < 4; ++d0) kf[d0] = *(const LAS bf16x8*)(Kl + (32 * kvt + r32) * 144 + (16 * d0 + 8 * hi_) * 2);
                            bf16x8 vf[2][2];
                            {
                                const int blk = (lane >> 4) & 1, qq = (lane & 15) >> 2, pp = lane & 3;
#pragma unroll
                                for (int db = 0; db < 2; ++db)
#pragma unroll
                                    for (int ks = 0; ks < 2; ++ks) {
                                        const LAS unsigned char* p0 = Vl + (32 * kvt + 16 * ks + 4 * hi_ + qq) * 144 + (32 * db + 16 * blk + 4 * pp) * 2;
                                        const s16x4 t0 = __builtin_bit_cast(s16x4, __builtin_amdgcn_ds_read_tr16_b64_v4i16((LAS s16x4*)p0));
                                        const s16x4 t1 = __builtin_bit_cast(s16x4, __builtin_amdgcn_ds_read_tr16_b64_v4i16((LAS s16x4*)(p0 + 8 * 144)));
                                        vf[db][ks] = (bf16x8){t0[0], t0[1], t0[2], t0[3], t1[0], t1[1], t1[2], t1[3]};
                                    }
                            }
#pragma unroll
                            for (int qt = 0; qt < 2; ++qt) {
                                const int i0 = qs + 32 * qt;
                                if (mtype == 1 && 32 * kvt + 31 < i0) continue;
                                if (mtype == 2 && 32 * kvt > i0 + 31) continue;
                                f32x16 s;
#pragma unroll
                                for (int r = 0; r < 16; ++r) s[r] = 0.f;
#pragma unroll
                                for (int d0 = 0; d0 < 4; ++d0) s = __builtin_amdgcn_mfma_f32_32x32x16_bf16(kf[d0], qf[qt][d0], s, 0, 0, 0);
                                const int iq = i0 + r32;
                                if (mtype != 0) {
#pragma unroll
                                    for (int r = 0; r < 16; ++r) { const int jj = 32 * kvt + (r & 3) + 8 * (r >> 2) + 4 * hi_;
                                        const bool ok = (mtype == 1) ? (jj >= iq) : (jj <= iq); s[r] = ok ? s[r] : -INFINITY; }
                                }
                                float tmax = s[0];
#pragma unroll
                                for (int r = 1; r < 16; ++r) tmax = fmaxf(tmax, s[r]);
                                tmax = fmaxf(tmax, __shfl_xor(tmax, 32));
                                const float mnew = fmaxf(mrun[qt], tmax);
                                const float scl = __builtin_amdgcn_exp2f(mrun[qt] - mnew);
                                mrun[qt] = mnew;
                                float psum = 0.f;
#pragma unroll
                                for (int r = 0; r < 16; ++r) { s[r] = __builtin_amdgcn_exp2f(s[r] - mnew); psum += s[r]; }
                                lrun[qt] = lrun[qt] * scl + psum;
#pragma unroll
                                for (int db = 0; db < 2; ++db)
#pragma unroll
                                    for (int r = 0; r < 16; ++r) o[qt][db][r] *= scl;
                                bf16x8 pf[2];
#pragma unroll
                                for (int ks = 0; ks < 2; ++ks) { u32x4 w; w.x = pk2(s[8 * ks + 0], s[8 * ks + 1]); w.y = pk2(s[8 * ks + 2], s[8 * ks + 3]); w.z = pk2(s[8 * ks + 4], s[8 * ks + 5]); w.w = pk2(s[8 * ks + 6], s[8 * ks + 7]); pf[ks] = __builtin_bit_cast(bf16x8, w); }
#pragma unroll
                                for (int db = 0; db < 2; ++db)
#pragma unroll
                                    for (int ks = 0; ks < 2; ++ks) o[qt][db] = __builtin_amdgcn_mfma_f32_32x32x16_bf16(vf[db][ks], pf[ks], o[qt][db], 0, 0, 0);
                            }
                        }
                    }
#pragma unroll
                    for (int qt = 0; qt < 2; ++qt) {
                        float lt = lrun[qt]; lt += __shfl_xor(lt, 32);
                        const float inv = 1.0f / lt;
                        bf16_t* orow = mix + (size_t)(qrow0 + qs + 32 * qt + r32) * D + hh * 64;
#pragma unroll
                        for (int db = 0; db < 2; ++db)
#pragma unroll
                            for (int rg = 0; rg < 4; ++rg) { u32x2 w; w.x = pk2(o[qt][db][4 * rg + 0] * inv, o[qt][db][4 * rg + 1] * inv); w.y = pk2(o[qt][db][4 * rg + 2] * inv, o[qt][db][4 * rg + 3] * inv);
                                *(u32x2*)(orow + 32 * db + 8 * rg + 4 * hi_) = w; }
                    }
                    __syncthreads();
                } else {
                    const int ch = uidx - n_att, row0 = ch * 128;
                    const int seqlen = (row0 < NLAT) ? SEQ : CTXL;
                    const int sbase = (row0 < NLAT) ? (row0 / SEQ) * SEQ : NLAT + ((row0 - NLAT) / CTXL) * CTXL;
                    {
                        const int c8 = (tid & 31) * 8, tg = tid >> 5;
                        float w0[8], w1[8], w2[8];
                        const float* cw = kp->in[I_CONVW] + (size_t)l * 3 * 256;
#pragma unroll
                        for (int j = 0; j < 8; ++j) { w0[j] = cw[c8 + j]; w1[j] = cw[256 + c8 + j]; w2[j] = cw[512 + c8 + j]; }
                        float zp[8], zc[8], zn[8];
                        auto loadz = [&](int row, float (&z)[8]) {
                            if (row < sbase || row >= sbase + seqlen) {
#pragma unroll
                                for (int j = 0; j < 8; ++j) z[j] = 0.f;
                            } else {
                                const u32x4 cc = *(const u32x4*)(proj + (size_t)row * INW + 1024 + c8), cx = *(const u32x4*)(proj + (size_t)row * INW + 1280 + c8);
                                z[0] = bflo(cc.x) * bflo(cx.x); z[1] = bfhi(cc.x) * bfhi(cx.x); z[2] = bflo(cc.y) * bflo(cx.y); z[3] = bfhi(cc.y) * bfhi(cx.y);
                                z[4] = bflo(cc.z) * bflo(cx.z); z[5] = bfhi(cc.z) * bfhi(cx.z); z[6] = bflo(cc.w) * bflo(cx.w); z[7] = bfhi(cc.w) * bfhi(cx.w);
                            }
                        };
                        const int t0 = row0 + tg * 8;
                        loadz(t0 - 1, zp); loadz(t0, zc);
#pragma unroll 1
                        for (int tt = 0; tt < 8; ++tt) {
                            const int row = t0 + tt;
                            loadz(row + 1, zn);
                            const u32x4 cb = *(const u32x4*)(proj + (size_t)row * INW + 768 + c8);
                            float bb[8] = {bflo(cb.x), bfhi(cb.x), bflo(cb.y), bfhi(cb.y), bflo(cb.z), bfhi(cb.z), bflo(cb.w), bfhi(cb.w)};
                            float y[8];
#pragma unroll
                            for (int j = 0; j < 8; ++j) y[j] = bb[j] * (zp[j] * w0[j] + zc[j] * w1[j] + zn[j] * w2[j]);
                            u32x4 ov; ov.x = pk2(y[0], y[1]); ov.y = pk2(y[2], y[3]); ov.z = pk2(y[4], y[5]); ov.w = pk2(y[6], y[7]);
                            *(u32x4*)(mix + (size_t)row * D + 512 + c8) = ov;
#pragma unroll
                            for (int j = 0; j < 8; ++j) { zp[j] = zc[j]; zc[j] = zn[j]; }
                        }
                    }
                    __syncthreads();
                    LAS unsigned char* Vg = lds;
                    for (int tt = wave; tt < 128; tt += 8) {
                        const int row = row0 + tt;
                        const u32x2 gvv = *(const u32x2*)(proj + (size_t)row * INW + 1792 + 4 * lane);
                        float v0 = gelu_tanh_f(bflo(gvv.x)), v1 = gelu_tanh_f(bfhi(gvv.x)), v2 = gelu_tanh_f(bflo(gvv.y)), v3 = gelu_tanh_f(bfhi(gvv.y));
                        const float mu = wave_sum((v0 + v1) + (v2 + v3)) * (1.0f / 256.0f);
                        v0 -= mu; v1 -= mu; v2 -= mu; v3 -= mu;
                        const float var = wave_sum((v0 * v0 + v1 * v1) + (v2 * v2 + v3 * v3)) * (1.0f / 256.0f);
                        const float rs = 1.0f / sqrtf(var + LN_EPS);
                        u32x2 w; w.x = pk2(v0 * rs, v1 * rs); w.y = pk2(v2 * rs, v3 * rs);
                        *(LAS u32x2*)(Vg + tt * 528 + lane * 8) = w;
                    }
                    __syncthreads();
                    {
                        const int gg = wave >> 1, ph = wave & 1, r32 = lane & 31, hi_ = lane >> 5;
                        const int blk = (lane >> 4) & 1, qq = (lane & 15) >> 2, pp = lane & 3;
                        const bf16_t* wsg = gmw + ((size_t)(l * 4 + gg) * 128) * 128;
                        f32x16 sacc[2][2];
#pragma unroll
                        for (int pt = 0; pt < 2; ++pt)
#pragma unroll
                            for (int ct = 0; ct < 2; ++ct)
#pragma unroll
                                for (int r = 0; r < 16; ++r) sacc[pt][ct][r] = 0.f;
#pragma unroll 2
                        for (int ks = 0; ks < 8; ++ks) {
                            bf16x8 af[2], bfr[2];
#pragma unroll
                            for (int ct = 0; ct < 2; ++ct) {
                                const LAS unsigned char* p0 = Vg + (16 * ks + 8 * hi_ + qq) * 528 + (gg * 64 + 32 * ct + 16 * blk + 4 * pp) * 2;
                                const s16x4 t0 = __builtin_bit_cast(s16x4, __builtin_amdgcn_ds_read_tr16_b64_v4i16((LAS s16x4*)p0));
                                const s16x4 t1 = __builtin_bit_cast(s16x4, __builtin_amdgcn_ds_read_tr16_b64_v4i16((LAS s16x4*)(p0 + 4 * 528)));
                                af[ct] = (bf16x8){t0[0], t0[1], t0[2], t0[3], t1[0], t1[1], t1[2], t1[3]};
                            }
#pragma unroll
                            for (int pt = 0; pt < 2; ++pt) bfr[pt] = *(const bf16x8*)(wsg + (size_t)(64 * ph + 32 * pt + r32) * 128 + 16 * ks + 8 * hi_);
#pragma unroll
                            for (int pt = 0; pt < 2; ++pt)
#pragma unroll
                                for (int ct = 0; ct < 2; ++ct) sacc[pt][ct] = __builtin_amdgcn_mfma_f32_32x32x16_bf16(af[ct], bfr[pt], sacc[pt][ct], 0, 0, 0);
                        }
#pragma unroll
                        for (int pt = 0; pt < 2; ++pt) {
                            const int p = 64 * ph + 32 * pt + r32, row = row0 + p;
                            const float bias = kp->in[I_GMBS][(l * 4 + gg) * 128 + p];
#pragma unroll
                            for (int ct = 0; ct < 2; ++ct)
#pragma unroll
                                for (int rg = 0; rg < 4; ++rg) {
                                    const int cc = gg * 64 + 32 * ct + 8 * rg + 4 * hi_;
                                    const u32x2 uu = *(const u32x2*)(proj + (size_t)row * INW + 1536 + cc);
                                    const float y0 = gelu_tanh_f(bflo(uu.x)) * (sacc[pt][ct][4 * rg + 0] + bias), y1 = gelu_tanh_f(bfhi(uu.x)) * (sacc[pt][ct][4 * rg + 1] + bias);
                                    const float y2 = gelu_tanh_f(bflo(uu.y)) * (sacc[pt][ct][4 * rg + 2] + bias), y3 = gelu_tanh_f(bfhi(uu.y)) * (sacc[pt][ct][4 * rg + 3] + bias);
                                    u32x2 w; w.x = pk2(y0, y1); w.y = pk2(y2, y3);
                                    *(u32x2*)(mix + (size_t)row * D + 768 + cc) = w;
                                }
                        }
                    }
                    __syncthreads();
                }
            }
        }
        GRID_BAR(pb + 1);

        if (IN(pb + 2)) {
            PHASE_PTRS();
            SchedPlain S; S.nM = nrow_l / 256; S.nN = 4; S.nX = 0; S.xpm0 = 0; S.xpn = 0; S.G = G; S.c = bx;
            S.rowbytes = D * 2; S.Bt = (const char*)(WoutT + (size_t)l * D * D); S.btile = (size_t)256 * D * 2;
            const float* s_lat = xbuf; const float* s_ctx = xbuf; if (l == 0) { s_lat = kp->in[I_X]; s_ctx = kp->in[I_CTX] - (size_t)NLAT * D; }
            EpiOut E{xbuf, s_lat, s_ctx, mod_l};
            pg8::gemm_phase<EpiOut, SchedPlain>(lds, (const char*)mix, D, S, E);
        }
        GRID_BAR(pb + 2);

        if (IN(pb + 3)) {
            PHASE_PTRS();
            LAS float* WrT = (LAS float*)lds;
            for (int i = tid; i < 36 * D; i += 512) {
                const int k = i / 36, o_ = i % 36;
                const float v = (o_ < 4) ? kp->in[I_WRG][((size_t)l * D + k) * 4 + o_] : kp->in[I_WRE][((size_t)l * D + k) * 32 + (o_ - 4)];
                WrT[o_ * D + k] = v;
            }
            LAS int* lcnt = (LAS int*)(lds + L_N1);
            LAS int* lbase = lcnt + 32;
            LAS int* rec = lbase + 32;
            const int RB = lastl ? 128 : 136;
            const int nblk = nrow_l / RB;
            const float* g1v = kp->in[I_LN1G] + l * D; const float* b1v = kp->in[I_LN1B] + l * D;
            for (int rb = bx; rb < nblk; rb += G) {
                if (tid < 32) lcnt[tid] = 0;
                __syncthreads();
                for (int rr = wave; rr < RB; rr += 8) {
                    const int row = rb * RB + rr;
                    float* xr = xbuf + (size_t)row * D;
                    const float* md = mod_l + (size_t)((row < NLAT) ? (row / SEQ) : 8) * 6144;
                    f32x4 v[4]; float s = 0.f;
#pragma unroll
                    for (int j = 0; j < 4; ++j) { v[j] = *(const f32x4*)(xr + 256 * j + 4 * lane); s += (v[j][0] + v[j][1]) + (v[j][2] + v[j][3]); }
                    const float mean = wave_sum(s) * (1.0f / D); float s2 = 0.f;
#pragma unroll
                    for (int j = 0; j < 4; ++j) { v[j] = v[j] - mean; s2 += (v[j][0] * v[j][0] + v[j][1] * v[j][1]) + (v[j][2] * v[j][2] + v[j][3] * v[j][3]); }
                    const float rstd = 1.0f / sqrtf(wave_sum(s2) * (1.0f / D) + LN_EPS);
                    f32x4 h[4];
#pragma unroll
                    for (int j = 0; j < 4; ++j) {
                        const int c = 256 * j + 4 * lane;
                        const f32x4 gg = *(const f32x4*)(g1v + c), bb = *(const f32x4*)(b1v + c);
                        const f32x4 x1 = v[j] * rstd * gg + bb;
                        *(f32x4*)(xr + c) = x1;
                        const f32x4 sh = *(const f32x4*)(md + 3 * D + c), sc = *(const f32x4*)(md + 4 * D + c);
                        h[j] = x1 * (1.0f + sc) + sh;
                        u32x2 w; w.x = pk2(h[j][0], h[j][1]); w.y = pk2(h[j][2], h[j][3]);
                        *(u32x2*)(hx + (size_t)row * D + c) = w;
                    }
                    float lg[36];
#pragma unroll
                    for (int o_ = 0; o_ < 36; ++o_) {
                        float a = 0.f;
#pragma unroll
                        for (int j = 0; j < 4; ++j) { const f32x4 w = *(const LAS f32x4*)(WrT + o_ * D + 256 * j + 4 * lane); a += (h[j][0] * w[0] + h[j][1] * w[1]) + (h[j][2] * w[2] + h[j][3] * w[3]); }
                        lg[o_] = wave_sum(a);
                    }
                    float gl[4];
#pragma unroll
                    for (int j = 0; j < 4; ++j) gl[j] = lg[j] + kp->in[I_BRG][l * 4 + j];
                    int gi = 0; float gm = gl[0];
#pragma unroll
                    for (int j = 1; j < 4; ++j) if (gl[j] > gm) { gm = gl[j]; gi = j; }
                    float gsum = 0.f;
#pragma unroll
                    for (int j = 0; j < 4; ++j) gsum += expf(gl[j] - gm);
                    const float pgrp = 1.0f / gsum;
                    float el[8];
#pragma unroll
                    for (int j = 0; j < 8; ++j) {
                        float vsel = lg[4 + j];
#pragma unroll
                        for (int q = 1; q < 4; ++q) vsel = (gi == q) ? lg[4 + 8 * q + j] : vsel;
                        el[j] = vsel + kp->in[I_BRE][l * 32 + gi * 8 + j];
                    }
                    int i1 = 0; float e1 = el[0];
#pragma unroll
                    for (int j = 1; j < 8; ++j) if (el[j] > e1) { e1 = el[j]; i1 = j; }
                    int i2 = -1; float e2 = -INFINITY;
#pragma unroll
                    for (int j = 0; j < 8; ++j) if (j != i1 && el[j] > e2) { e2 = el[j]; i2 = j; }
                    const float ex = expf(e2 - e1);
                    const float ga = pgrp / (1.0f + ex), gb = pgrp * ex / (1.0f + ex);
                    if (lane == 0) {
                        const int ea = gi * 8 + i1, eb = gi * 8 + i2;
                        const int ra = atomicAdd((int*)&lcnt[ea], 1), rb2 = atomicAdd((int*)&lcnt[eb], 1);
                        rec[rr * 4 + 0] = ea; rec[rr * 4 + 1] = ra; rec[rr * 4 + 2] = eb; rec[rr * 4 + 3] = rb2;
                        *(f32x2*)(gates + (size_t)row * 2) = (f32x2){ga, gb};
                    }
                }
                __syncthreads();
                if (tid < 32) lbase[tid] = (int)__hip_atomic_fetch_add(cnt_l + tid, (unsigned)lcnt[tid], __ATOMIC_RELAXED, __HIP_MEMORY_SCOPE_AGENT);
                __syncthreads();
                if (tid < RB) {
                    const int row = rb * RB + tid;
                    const int ea = rec[tid * 4 + 0], ra = lbase[ea] + rec[tid * 4 + 1], eb = rec[tid * 4 + 2], rb2 = lbase[eb] + rec[tid * 4 + 3];
                    elist[(size_t)ea * NROW + ra] = row; elist[(size_t)eb * NROW + rb2] = row;
                    *(int4*)(tokinfo + (size_t)row * 4) = make_int4(ea, ra, eb, rb2);
                }
                __syncthreads();
            }
        }
        GRID_BAR(pb + 3);

        LAS int* tile_e = (LAS int*)(lds + L_TILE_E); LAS int* tile_r0 = (LAS int*)(lds + L_TILE_R0); LAS int* tile_j = (LAS int*)(lds + L_TILE_J);
        LAS int* pstart = (LAS int*)(lds + L_PSTART); LAS int* ecnt = (LAS int*)(lds + L_CNT); LAS int* ntile_p = (LAS int*)(lds + L_NT);
        if (IN(pb + 4) || IN(pb + 5) || IN(pb + 6)) {
            PHASE_PTRS();
            __syncthreads();
            if (tid < 64) {
                const int e = tid & 31;
                const int c = (int)__hip_atomic_load(cnt_l + e, __ATOMIC_RELAXED, __HIP_MEMORY_SCOPE_AGENT);
                const int nt_ = (c + 255) >> 8;
                int inc = nt_;
#pragma unroll
                for (int o = 1; o < 32; o <<= 1) { const int v = __shfl_up(inc, o, 32); if (e >= o) inc += v; }
                const int tb = inc - nt_;
                if (tid < 32) {
                    ecnt[e] = c; pstart[e] = tb * 256;
#pragma nounroll
                    for (int j = 0; j < nt_; ++j) { tile_e[tb + j] = e; tile_r0[tb + j] = (tb + j) * 256; tile_j[tb + j] = j; }
                    if (e == 31) ntile_p[0] = inc;
                }
            }
            __syncthreads();
        }

        if (IN(pb + 4)) {
            PHASE_PTRS();
            const int ntile = __builtin_amdgcn_readfirstlane(ntile_p[0]);
            LAS int* idx = (LAS int*)(lds + L_IDX);
            for (int i = 0; i < 8; ++i) {
                const int L = i * G + bx; if (L >= 4 * ntile) break;
                const int t = L >> 2, e = tile_e[t], j = tile_j[t], ce = ecnt[e];
                if (tid < 256) { const int rr = j * 256 + tid; const int tok = elist[(size_t)e * NROW + (rr < ce ? rr : 0)]; idx[i * 256 + tid] = tok * (D * 2); }
            }
            __syncthreads();
            SchedMoe<true> S; S.ntile = ntile; S.G = G; S.c = bx; S.rowbytes = D * 2; S.Bt = (const char*)W13T; S.btile = (size_t)256 * D * 2; S.bexp = (size_t)1024 * D * 2;
            S.tile_e = tile_e; S.tile_r0 = tile_r0; S.idx = idx;
            EpiH E{Hb};
            pg8::gemm_phase<EpiH, SchedMoe<true>>(lds, (const char*)hx, D, S, E);
        }
        GRID_BAR(pb + 4);

        if (IN(pb + 5)) {
            PHASE_PTRS();
            const int ntile = __builtin_amdgcn_readfirstlane(ntile_p[0]);
            SchedMoe<false> S; S.ntile = ntile; S.G = G; S.c = bx; S.rowbytes = DE * 2; S.Bt = (const char*)W2T; S.btile = (size_t)256 * DE * 2; S.bexp = (size_t)1024 * DE * 2;
            S.tile_e = tile_e; S.tile_r0 = tile_r0; S.idx = nullptr;
            EpiY E{Yb};
            pg8::gemm_phase<EpiY, SchedMoe<false>>(lds, (const char*)Hb, DE, S, E);
        }
        GRID_BAR(pb + 5);

        if (IN(pb + 6)) {
            PHASE_PTRS();
            const float* g2v = kp->in[I_LN2G] + l * D; const float* b2v = kp->in[I_LN2B] + l * D;
            const float* mod_n = modall + (size_t)(l + 1) * 9 * 6144;
            for (int row = gw; row < nrow_l; row += NGW) {
                const int mr = (row < NLAT) ? (row / SEQ) : 8;
                const float* md = mod_l + (size_t)mr * 6144;
                const int4 ti = *(const int4*)(tokinfo + (size_t)row * 4);
                const f32x2 gt = *(const f32x2*)(gates + (size_t)row * 2);
                const bf16_t* ya = Yb + (size_t)(pstart[ti.x] + ti.y) * D; const bf16_t* yb = Yb + (size_t)(pstart[ti.z] + ti.w) * D;
                const float* xr = xbuf + (size_t)row * D;
                f32x4 v[4]; float s = 0.f;
#pragma unroll
                for (int j = 0; j < 4; ++j) {
                    const int c = 256 * j + 4 * lane;
                    const f32x4 x1 = *(const f32x4*)(xr + c), g2 = *(const f32x4*)(md + 5 * D + c);
                    const u32x2 a = *(const u32x2*)(ya + c), b = *(const u32x2*)(yb + c);
                    f32x4 y; y[0] = gt[0] * bflo(a.x) + gt[1] * bflo(b.x); y[1] = gt[0] * bfhi(a.x) + gt[1] * bfhi(b.x); y[2] = gt[0] * bflo(a.y) + gt[1] * bflo(b.y); y[3] = gt[0] * bfhi(a.y) + gt[1] * bfhi(b.y);
                    v[j] = ALPHA * x1 + g2 * y;
                    s += (v[j][0] + v[j][1]) + (v[j][2] + v[j][3]);
                }
                const float mean = wave_sum(s) * (1.0f / D); float s2 = 0.f;
#pragma unroll
                for (int j = 0; j < 4; ++j) { v[j] = v[j] - mean; s2 += (v[j][0] * v[j][0] + v[j][1] * v[j][1]) + (v[j][2] * v[j][2] + v[j][3] * v[j][3]); }
                const float rstd = 1.0f / sqrtf(wave_sum(s2) * (1.0f / D) + LN_EPS);
                float* dst = lastl ? (kp->out + (size_t)row * D) : (xbuf + (size_t)row * D);
#pragma unroll
                for (int j = 0; j < 4; ++j) {
                    const int c = 256 * j + 4 * lane;
                    const f32x4 gg = *(const f32x4*)(g2v + c), bb = *(const f32x4*)(b2v + c);
                    const f32x4 x2 = v[j] * rstd * gg + bb;
                    *(f32x4*)(dst + c) = x2;
                    if (!lastl) {
                        const f32x4 sh = *(const f32x4*)(mod_n + (size_t)mr * 6144 + c), sc = *(const f32x4*)(mod_n + (size_t)mr * 6144 + D + c);
                        const f32x4 hn = x2 * (1.0f + sc) + sh;
                        u32x2 w; w.x = pk2(hn[0], hn[1]); w.y = pk2(hn[2], hn[3]);
                        *(u32x2*)(hx + (size_t)row * D + c) = w;
                    }
                }
            }
            if (!lastl) {
                __syncthreads();
                LAS float* scr = (LAS float*)(lds + wave * 9216);
                convert_experts(kp->in[I_W1], kp->in[I_W3], kp->in[I_W2], W13T, W2T, l + 1, scr, gw, NGW, lane);
            }
        }
        if (!lastl) GRID_BAR(pb + 6);
    }
#undef IN
#undef GRID_BAR
}

extern "C" void kernel_launch(void* const* d_in, const int* in_sizes, int n_in, void* d_out, int out_size, void* d_ws, size_t ws_size, hipStream_t stream) {
    static int grid = 0;
    if (grid == 0) {
        if (n_in != 23 || out_size != NLAT * D || ws_size < WS_END) { fprintf(stderr, "kernel_launch: unexpected shapes (n_in %d out %d ws %zu)\n", n_in, out_size, ws_size); grid = -1; return; }
        int dev = 0, cus = 0, per_cu = 0;
        if (hipGetDevice(&dev) != hipSuccess || hipDeviceGetAttribute(&cus, hipDeviceAttributeMultiprocessorCount, dev) != hipSuccess) { grid = -1; return; }
        if (hipFuncSetAttribute((const void*)fwd_kernel, hipFuncAttributeMaxDynamicSharedMemorySize, LDS_BYTES) != hipSuccess) { fprintf(stderr, "kernel_launch: hipFuncSetAttribute failed\n"); grid = -1; return; }
        if (hipOccupancyMaxActiveBlocksPerMultiprocessor(&per_cu, (const void*)fwd_kernel, 512, LDS_BYTES) != hipSuccess || per_cu < 1) { fprintf(stderr, "kernel_launch: occupancy query says %d\n", per_cu); }
        (void)hipGetLastError();
        grid = cus;
    }
    if (grid < 0) return;
    if (hipMemsetAsync((char*)d_ws + WS_CTL, 0, CTL_ZERO_BYTES, stream) != hipSuccess) return;
    Args a{};
    for (int i = 0; i < 23; ++i) a.in[i] = (const float*)d_in[i];
    a.out = (float*)d_out; a.ws = (unsigned char*)d_ws;
#if MK_N_LAUNCHES == 1
    a.ph_lo = 0; a.ph_hi = NPH;
    hipLaunchKernelGGL(fwd_kernel, dim3(grid), dim3(512), LDS_BYTES, stream, a);
#else
    for (int p = 0; p < NPH; ++p) { a.ph_lo = p; a.ph_hi = p + 1; hipLaunchKernelGGL(fwd_kernel, dim3(grid), dim3(512), LDS_BYTES, stream, a); }
#endif
}
```

```cpp
#include <hip/hip_runtime.h>
#include <cstdio>
#include <cstdint>

#ifndef MK_N_LAUNCHES
#define MK_N_LAUNCHES 1
#endif

#define LAS __attribute__((address_space(3)))
#define GAS __attribute__((address_space(1)))
typedef unsigned short bf16_t;
typedef short bf16x8 __attribute__((ext_vector_type(8)));
typedef short s16x4 __attribute__((ext_vector_type(4)));
typedef float f32x2 __attribute__((ext_vector_type(2)));
typedef float f32x4 __attribute__((ext_vector_type(4)));
typedef float f32x16 __attribute__((ext_vector_type(16)));
typedef unsigned u32x2 __attribute__((ext_vector_type(2)));
typedef unsigned u32x4 __attribute__((ext_vector_type(4)));
typedef GAS unsigned gu32;

constexpr int D = 1024, NB = 8, SEQ = 4096, CTXL = 256, DEPTH = 2;
constexpr int NLAT = NB * SEQ, NCTX = NB * CTXL, NROW = NLAT + NCTX;
constexpr int INW = 2048, NE = 32, DE = 512;
constexpr int MAXSLOT = 77824;
constexpr float ALPHA = 1.4142135623730951f;
constexpr float LN_EPS = 1e-6f;
constexpr float LOG2E = 1.4426950408889634f;
constexpr float QSCALE = 0.125f * LOG2E;

constexpr size_t MiB = 1u << 20;
constexpr size_t WS_CTL = 0, CTL_ZERO_BYTES = 1 * MiB;
constexpr size_t WS_MOD = 1 * MiB;
constexpr size_t WS_ROPE = 1 * MiB + 512 * 1024;
constexpr size_t WS_GMW = 1 * MiB + 768 * 1024;
constexpr size_t WS_TOKINFO = 2 * MiB;
constexpr size_t WS_GATES = 3 * MiB;
constexpr size_t WS_LIST = 4 * MiB;
constexpr size_t WS_WIN = 10 * MiB;
constexpr size_t WS_WOUT = 18 * MiB;
constexpr size_t WS_W13 = 22 * MiB;
constexpr size_t WS_W2 = 86 * MiB;
constexpr size_t WS_HX = 118 * MiB;
constexpr size_t WS_XBUF = 186 * MiB;
constexpr size_t WS_PROJ = 322 * MiB;
constexpr size_t WS_MIX = 458 * MiB;
constexpr size_t WS_H = 322 * MiB;
constexpr size_t WS_Y = 398 * MiB;
constexpr size_t WS_END = 550 * MiB;
static_assert(WS_H + (size_t)MAXSLOT * DE * 2 <= WS_Y && WS_Y + (size_t)MAXSLOT * D * 2 <= WS_END, "ws map");
static_assert(WS_PROJ + (size_t)NROW * INW * 2 <= WS_MIX && WS_MIX + (size_t)NROW * D * 2 <= WS_END, "ws map");
static_assert(WS_LIST + (size_t)NE * NROW * 4 <= WS_WIN, "ws map");
constexpr int CW_BAR = 4096;
constexpr int CW_CNT = 8192;

constexpr int LDS_BYTES = 163840;
constexpr int RING_BYTES = 131072;
constexpr int L_TILE_E = 131072, L_TILE_R0 = L_TILE_E + 1280, L_TILE_J = L_TILE_R0 + 1280, L_PSTART = L_TILE_J + 1280, L_CNT = L_PSTART + 128, L_NT = L_CNT + 128;
constexpr int L_IDX = 131072 + 8192;
constexpr int L_N1 = 147456;
constexpr int MISC_OFF = LDS_BYTES - 256;

__device__ __forceinline__ unsigned f2bf(float f) { unsigned u = __builtin_bit_cast(unsigned, f); return (u + 0x7fffu + ((u >> 16) & 1u)) >> 16; }
__device__ __forceinline__ unsigned pk2(float lo, float hi) { return f2bf(lo) | (f2bf(hi) << 16); }
__device__ __forceinline__ float bf2f(unsigned short b) { return __builtin_bit_cast(float, ((unsigned)b) << 16); }
__device__ __forceinline__ float bflo(unsigned w) { return __builtin_bit_cast(float, w << 16); }
__device__ __forceinline__ float bfhi(unsigned w) { return __builtin_bit_cast(float, w & 0xffff0000u); }
__device__ __forceinline__ float wave_sum(float v) {
#pragma unroll
    for (int o = 1; o < 64; o <<= 1) v += __shfl_xor(v, o);
    return v;
}
__device__ __forceinline__ float silu_f(float x) { return x / (1.0f + __expf(-x)); }
__device__ __forceinline__ float gelu_tanh_f(float x) {
    const float z = 0.7978845608028654f * (x + 0.044715f * x * x * x);
    const float t = 1.0f - 2.0f / (1.0f + __expf(2.0f * z));
    return 0.5f * x * (1.0f + t);
}
#define LDS_WAIT() asm volatile("s_waitcnt lgkmcnt(0)" ::: "memory")
#define VM_WAIT() asm volatile("s_waitcnt vmcnt(0)" ::: "memory")

#define XB_TMO      128
#define XB_XCNT(j)  (256  + 64 * (j))
#define XB_XSUB(j)  (1280 + 64 * (j))
#define XB_XGEN(j)  (2304 + 64 * (j))
#define XB_TOP      3328
#define XB_TOPGEN   3392
#define XCD_BAR_WORDS 3456
#define XB_SPIN_CAP (1u << 18)
__device__ __forceinline__ unsigned xb_ld(unsigned* p)              { return __hip_atomic_load(p, __ATOMIC_RELAXED, __HIP_MEMORY_SCOPE_AGENT); }
__device__ __forceinline__ unsigned xb_add(unsigned* p, unsigned v) { return __hip_atomic_fetch_add(p, v, __ATOMIC_RELAXED, __HIP_MEMORY_SCOPE_AGENT); }
__device__ __forceinline__ unsigned xb_xcc_id() { return (unsigned)__builtin_amdgcn_s_getreg((3 << 11) | 20) & 0xFu; }
#define XB_SPIN(cond, bar) do { unsigned _sp = 0; while (cond) { __builtin_amdgcn_s_sleep(1); \
    if ((++_sp & 255u) == 0u) { if (xb_ld(&(bar)[XB_TMO])) break; if (_sp > XB_SPIN_CAP) { atomicAdd(&(bar)[XB_TMO], 1u); break; } } } } while (0)
struct XcdBarrier { unsigned* bar; unsigned x; volatile LAS unsigned* st; };
__device__ __forceinline__ XcdBarrier xcd_barrier_post(unsigned* bar, volatile LAS unsigned* st) {
    XcdBarrier b; b.bar = bar; b.x = xb_xcc_id(); b.st = st;
    if (threadIdx.x == 0) (void)xb_add(&bar[XB_XCNT(b.x)], 1u);
    return b;
}
__device__ __forceinline__ void xcd_barrier_complete(unsigned* bar, unsigned x, unsigned& nloc, unsigned& nx) {
    const unsigned G = gridDim.x * gridDim.y * gridDim.z;
    unsigned sum, cnt, mine, sp = 0u;
    for (;;) {
        sum = 0u; cnt = 0u; mine = 0u;
#pragma unroll
        for (unsigned j = 0; j < 16; ++j) { const unsigned c = xb_ld(&bar[XB_XCNT(j)]); sum += c; cnt += (c > 0u) ? 1u : 0u; mine = (j == x) ? c : mine; }
        if (sum == G) break;
        __builtin_amdgcn_s_sleep(1);
        if ((++sp & 255u) == 0u) { if (xb_ld(&bar[XB_TMO])) break; if (sp > XB_SPIN_CAP) { atomicAdd(&bar[XB_TMO], 1u); break; } }
    }
    nloc = mine > 0u ? mine : 1u; nx = cnt > 0u ? cnt : 1u;
}
__device__ __forceinline__ void xcd_barrier(const XcdBarrier& b) {
    asm volatile("s_waitcnt vmcnt(0)" ::: "memory");
    __syncthreads();
    if (threadIdx.x == 0) {
        unsigned* bar = b.bar;
        __builtin_amdgcn_s_waitcnt(0);
        unsigned nloc = b.st[0], nx = b.st[1];
        if (nloc == 0u) { xcd_barrier_complete(bar, b.x, nloc, nx); b.st[0] = nloc; b.st[1] = nx; }
        const unsigned old = xb_add(&bar[XB_XSUB(b.x)], 1u);
        const unsigned gen = old / nloc;
        if (old + 1u == (gen + 1u) * nloc) {
            __builtin_amdgcn_fence(__ATOMIC_RELEASE, "agent");
            asm volatile("s_waitcnt vmcnt(0)" ::: "memory");
            const unsigned og = xb_add(&bar[XB_TOP], 1u);
            const unsigned tg = og / nx;
            if (og + 1u == (tg + 1u) * nx) xb_add(&bar[XB_TOPGEN], 1u);
            else XB_SPIN(xb_ld(&bar[XB_TOPGEN]) == tg, bar);
            __builtin_amdgcn_fence(__ATOMIC_ACQUIRE, "agent");
            xb_add(&bar[XB_XGEN(b.x)], 1u);
            asm volatile("s_waitcnt vmcnt(0)" ::: "memory");
        } else {
            XB_SPIN(xb_ld(&bar[XB_XGEN(b.x)]) == gen, bar);
            __builtin_amdgcn_fence(__ATOMIC_ACQUIRE, "agent");
            asm volatile("s_waitcnt vmcnt(0)" ::: "memory");
        }
    }
    __syncthreads();
}

namespace pg8 {
constexpr int BM = 256, BK = 64, HALF = 128, HTB = HALF * BK * 2, STAGE_BYTES = 8 * HTB, NXCD = 8, WGM = 8;
__device__ __forceinline__ int lds_byte(int r, int c) { const int st = (r >> 4) * 2 + (c >> 5), rr = r & 15, cc = c & 31, ob = rr * 64 + cc * 2; return st * 1024 + (ob ^ (((ob >> 9) & 1) << 5)); }
__device__ __forceinline__ void stage_rc(int b, int& R, int& C) { const int st = b / 1024, sb = b % 1024, swz = sb ^ (((sb >> 9) & 1) << 5); R = (st >> 1) * 16 + swz / 64; C = (st & 1) * 32 + (swz % 64) / 2; }

struct Unit { int pm, pn, e, r0, slot; };
__device__ __forceinline__ void swz_tile(int wgid, int nM, int nN, int& pm, int& pn) {
    const int nwg = nM * nN;
    { const int q = nwg / NXCD, r = nwg % NXCD, xcd = wgid % NXCD, off = wgid / NXCD; wgid = (xcd < r ? xcd * (q + 1) : r * (q + 1) + (xcd - r) * q) + off; }
    const int nig = WGM * nN, gid = wgid / nig, fm = gid * WGM, gsz = (nM - fm) < WGM ? (nM - fm) : WGM;
    pm = fm + ((wgid % nig) % gsz); pn = (wgid % nig) / gsz;
}

template <class Epi, class Sched>
__device__ __forceinline__ void gemm_phase(LAS unsigned char* lds, const char* Abase, const int K, const Sched& S, const Epi& E) {
    int tid = threadIdx.x; asm volatile("" : "+v"(tid));
    const int wid = __builtin_amdgcn_readfirstlane(tid >> 6), lane = tid & 63, wr = wid >> 2, wc = wid & 3, fr = lane & 15, fq = lane >> 4;
    const int nt = K / BK;
    unsigned voffB[2];
#pragma unroll
    for (int i = 0; i < 2; ++i) { int R_, C_; stage_rc(tid * 16 + i * 8192, R_, C_); voffB[i] = (unsigned)(R_ * K + C_) * 2u; }
#define PG8_ROWOFFS(U, o00, o01, o10, o11) do { int t_ = tid; asm volatile("" : "+v"(t_)); int R0_, C0_, R1_, C1_; stage_rc(t_ * 16, R0_, C0_); stage_rc(t_ * 16 + 8192, R1_, C1_); \
        o00 = S.a_rowoff(U, R0_) + C0_ * 2; o01 = S.a_rowoff(U, R1_) + C1_ * 2; o10 = S.a_rowoff(U, HALF + R0_) + C0_ * 2; o11 = S.a_rowoff(U, HALF + R1_) + C1_ * 2; } while (0)
    const size_t kstep = (size_t)(BK * 2);
    const size_t hstep = (size_t)HALF * K * 2;
    const unsigned ldsw = (unsigned)wid * 1024u;
    const int aoff = lds_byte(wr * 64 + fr, fq * 8), boff = lds_byte(wc * 32 + fr, fq * 8);
#define PG8_SA(b, h) (((b) * 2 + (h)) * HTB)
#define PG8_SB(b, h) ((4 + (b) * 2 + (h)) * HTB)
#define PG8_STAGE_B(bufoff, gbase) do { _Pragma("unroll") for (int _i = 0; _i < 2; ++_i) \
        __builtin_amdgcn_global_load_lds((const unsigned*)((const char*)(gbase) + voffB[_i]), (LAS unsigned*)(lds + (bufoff) + ldsw + _i * 8192), 16, 0, 0); } while (0)
#define PG8_STAGE_A(bufoff, gbase, o0, o1) do { \
        __builtin_amdgcn_global_load_lds((const unsigned*)((const char*)(gbase) + (o0)), (LAS unsigned*)(lds + (bufoff) + ldsw), 16, 0, 0); \
        __builtin_amdgcn_global_load_lds((const unsigned*)((const char*)(gbase) + (o1)), (LAS unsigned*)(lds + (bufoff) + ldsw + 8192), 16, 0, 0); } while (0)
#define PG8_LDA(dst, b, h) do { _Pragma("unroll") for (int m = 0; m < 4; ++m) _Pragma("unroll") for (int k = 0; k < 2; ++k) dst[m][k] = *(const LAS bf16x8*)(lds + PG8_SA(b, h) + aoff + m * 2048 + k * 1024); } while (0)
#define PG8_LDB(dst, b, h) do { _Pragma("unroll") for (int n = 0; n < 2; ++n) _Pragma("unroll") for (int k = 0; k < 2; ++k) dst[n][k] = *(const LAS bf16x8*)(lds + PG8_SB(b, h) + boff + n * 2048 + k * 1024); } while (0)
#define PG8_MMA(ai, bj, At, Bt) do { __builtin_amdgcn_s_setprio(1); _Pragma("unroll") for (int m = 0; m < 4; ++m) _Pragma("unroll") for (int n = 0; n < 2; ++n) _Pragma("unroll") for (int k = 0; k < 2; ++k) \
        acc[ai][bj][m][n] = __builtin_amdgcn_mfma_f32_16x16x32_bf16(Bt[n][k], At[m][k], acc[ai][bj][m][n], 0, 0, 0); __builtin_amdgcn_s_setprio(0); } while (0)
#define PG8_WAIT_V(n) asm volatile("s_waitcnt vmcnt(" #n ")" ::: "memory")
#define PG8_WAIT_L(n) asm volatile("s_waitcnt lgkmcnt(" #n ")" ::: "memory")
#define PG8_BAR __builtin_amdgcn_s_barrier()
#define PG8_SCHED __builtin_amdgcn_sched_barrier(0)
    Unit cur, nxt; int ui = 0;
    if (!S.next(0, cur)) return;
    f32x4 acc[2][2][4][2];
#pragma unroll
    for (int a = 0; a < 2; ++a)
#pragma unroll
        for (int b = 0; b < 2; ++b)
#pragma unroll
            for (int m = 0; m < 4; ++m)
#pragma unroll
                for (int n = 0; n < 2; ++n) acc[a][b][m][n] = (f32x4){0.f, 0.f, 0.f, 0.f};
    bf16x8 At[4][2], B0[2][2], B1[2][2];
    unsigned c00, c01, c10, c11, n00, n01, n10, n11;
    PG8_ROWOFFS(cur, c00, c01, c10, c11);
    const char* cB = S.b_ptr(cur);
    const char* cA = Abase;
    PG8_STAGE_B(PG8_SB(0, 0), cB); PG8_STAGE_B(PG8_SB(0, 1), cB + hstep); PG8_STAGE_A(PG8_SA(0, 0), cA, c00, c01); PG8_STAGE_A(PG8_SA(0, 1), cA, c10, c11);
    if (wr == 1) PG8_BAR;
    PG8_WAIT_V(2); PG8_BAR;
    PG8_STAGE_B(PG8_SB(1, 0), cB + kstep); PG8_STAGE_A(PG8_SA(1, 0), cA + kstep, c00, c01); PG8_STAGE_B(PG8_SB(1, 1), cB + hstep + kstep);
    PG8_WAIT_V(6); PG8_BAR;
    for (;;) {
        const bool has_next = S.next(ui + 1, nxt);
        const char* nB = has_next ? S.b_ptr(nxt) : cB;
        if (has_next) { PG8_ROWOFFS(nxt, n00, n01, n10, n11); }
        else { n00 = c00; n01 = c01; n10 = c10; n11 = c11; }
        for (int t = 0; t < nt; t += 2) {
            const bool last = (t == nt - 2);
            const char* a1 = cA + (size_t)(t + 1) * kstep;
            const char* a2 = last ? cA : cA + (size_t)(t + 2) * kstep; const char* b2 = last ? nB : cB + (size_t)(t + 2) * kstep;
            const char* a3 = a2 + kstep; const char* b3 = b2 + kstep;
            const unsigned x00 = last ? n00 : c00, x01 = last ? n01 : c01, x10 = last ? n10 : c10, x11 = last ? n11 : c11;
            PG8_LDB(B0, 0, 0); PG8_LDB(B1, 0, 1); PG8_SCHED; PG8_LDA(At, 0, 0); PG8_STAGE_A(PG8_SA(1, 1), a1, c10, c11);
            PG8_WAIT_V(8); PG8_WAIT_L(0); PG8_BAR; PG8_MMA(0, 0, At, B0); PG8_MMA(0, 1, At, B1); PG8_BAR; PG8_SCHED;
            PG8_LDA(At, 0, 1); PG8_STAGE_B(PG8_SB(0, 0), b2); PG8_STAGE_B(PG8_SB(0, 1), b2 + hstep); PG8_STAGE_A(PG8_SA(0, 0), a2, x00, x01);
            PG8_WAIT_V(8); PG8_WAIT_L(0); PG8_BAR; PG8_MMA(1, 0, At, B0); PG8_MMA(1, 1, At, B1); PG8_BAR; PG8_SCHED;
            PG8_LDB(B0, 1, 0); PG8_LDB(B1, 1, 1); PG8_SCHED; PG8_LDA(At, 1, 0); PG8_STAGE_A(PG8_SA(0, 1), a2, x10, x11);
            PG8_WAIT_V(8); PG8_WAIT_L(0); PG8_BAR; PG8_MMA(0, 0, At, B0); PG8_MMA(0, 1, At, B1); PG8_BAR; PG8_SCHED;
            PG8_LDA(At, 1, 1); PG8_STAGE_B(PG8_SB(1, 0), b3); PG8_STAGE_B(PG8_SB(1, 1), b3 + hstep); PG8_STAGE_A(PG8_SA(1, 0), a3, x00, x01);
            PG8_WAIT_V(8); PG8_WAIT_L(0); PG8_BAR; PG8_MMA(1, 0, At, B0); PG8_MMA(1, 1, At, B1); PG8_BAR; PG8_SCHED;
        }
        if (wr == 0) PG8_BAR;
        E(acc, cur, wr, wc, fr, fq);
        if (!has_next) break;
#pragma unroll
        for (int a = 0; a < 2; ++a)
#pragma unroll
            for (int b = 0; b < 2; ++b)
#pragma unroll
                for (int m = 0; m < 4; ++m)
#pragma unroll
                    for (int n = 0; n < 2; ++n) acc[a][b][m][n] = (f32x4){0.f, 0.f, 0.f, 0.f};
        cur = nxt; cB = nB; c00 = n00; c01 = n01; c10 = n10; c11 = n11; ++ui;
        if (wr == 1) PG8_BAR;
    }
    PG8_WAIT_V(0);
    PG8_BAR;
#undef PG8_ROWOFFS
#undef PG8_SA
#undef PG8_SB
#undef PG8_STAGE_A
#undef PG8_STAGE_B
#undef PG8_LDA
#undef PG8_LDB
#undef PG8_MMA
#undef PG8_WAIT_V
#undef PG8_WAIT_L
#undef PG8_BAR
#undef PG8_SCHED
}
}
using pg8::Unit;

struct SchedPlain {
    int nM, nN, nX, xpm0, xpn, G, c; unsigned rowbytes; const char* Bt; size_t btile;
    __device__ __forceinline__ bool next(int i, Unit& u) const {
        const int L = i * G + c, nwg = nM * nN;
        if (L < nwg) { pg8::swz_tile(L, nM, nN, u.pm, u.pn); }
        else if (L < nwg + nX) { u.pm = xpm0 + (L - nwg); u.pn = xpn; }
        else return false;
        u.e = 0; u.r0 = u.pm * 256; u.slot = i; return true;
    }
    __device__ __forceinline__ unsigned a_rowoff(const Unit& u, int r) const { return (unsigned)(u.r0 + r) * rowbytes; }
    __device__ __forceinline__ const char* b_ptr(const Unit& u) const { return Bt + (size_t)u.pn * btile; }
};
template <bool GATHER> struct SchedMoe {
    int ntile, G, c; unsigned rowbytes; const char* Bt; size_t btile, bexp;
    LAS const int* tile_e; LAS const int* tile_r0; LAS const int* idx;
    __device__ __forceinline__ bool next(int i, Unit& u) const {
        const int L = i * G + c; if (L >= 4 * ntile) return false;
        const int t = L >> 2; u.pn = L & 3; u.pm = t; u.e = __builtin_amdgcn_readfirstlane(tile_e[t]); u.r0 = __builtin_amdgcn_readfirstlane(tile_r0[t]); u.slot = i; return true;
    }
    __device__ __forceinline__ unsigned a_rowoff(const Unit& u, int r) const {
        if (GATHER) return (unsigned)idx[u.slot * 256 + r];
        else return (unsigned)(u.r0 + r) * rowbytes;
    }
    __device__ __forceinline__ const char* b_ptr(const Unit& u) const { return Bt + (size_t)u.e * bexp + (size_t)u.pn * btile; }
};

struct EpiProj {
    bf16_t* O; const float* rope;
    __device__ __forceinline__ void operator()(const f32x4 (&acc)[2][2][4][2], const Unit& u, int wr, int wc, int fr, int fq) const {
        const int row0 = u.pm * 256 + wr * 64 + fr, col0 = u.pn * 256 + wc * 32 + 4 * fq;
        const bool lat = (u.pm * 256) < NLAT;
        const float qs = (u.pn < 2) ? QSCALE : 1.0f;
#pragma unroll
        for (int ai = 0; ai < 2; ++ai)
#pragma unroll
            for (int m = 0; m < 4; ++m) {
                const int row = row0 + ai * 128 + m * 16;
                bf16_t* rowp = O + (size_t)row * INW + col0;
                const int t = row & (SEQ - 1);
                const int pos = (wc & 1) ? (t & 63) : (t >> 6);
                f32x4 cs = (f32x4){1.f, 1.f, 1.f, 1.f}, sn = (f32x4){0.f, 0.f, 0.f, 0.f};
                if (lat && u.pn <= 2) { cs = *(const f32x4*)(rope + pos * 16 + 4 * fq); sn = *(const f32x4*)(rope + 1024 + pos * 16 + 4 * fq); }
#pragma unroll
                for (int bj = 0; bj < 2; ++bj) {
                    f32x4 a = acc[ai][bj][m][0], b = acc[ai][bj][m][1];
                    const bool rot = lat && (u.pn < 2 || (u.pn == 2 && bj == 0));
                    if (rot) { const f32x4 na = a * cs - b * sn, nb = b * cs + a * sn; a = na; b = nb; }
                    a *= qs; b *= qs;
                    u32x2 w0, w1; w0.x = pk2(a[0], a[1]); w0.y = pk2(a[2], a[3]); w1.x = pk2(b[0], b[1]); w1.y = pk2(b[2], b[3]);
                    *(u32x2*)(rowp + bj * 128) = w0; *(u32x2*)(rowp + bj * 128 + 16) = w1;
                }
            }
    }
};
struct EpiOut {
    float* xbuf; const float* src_lat; const float* src_ctx; const float* mod_l;
    __device__ __forceinline__ void operator()(const f32x4 (&acc)[2][2][4][2], const Unit& u, int wr, int wc, int fr, int fq) const {
        const int row0 = u.pm * 256 + wr * 64 + fr, col0 = u.pn * 256 + wc * 32 + 4 * fq;
        const int tr0 = u.pm * 256;
        const bool lat = tr0 < NLAT;
        const int mr = lat ? (tr0 / SEQ) : 8;
        const float* gate = mod_l + mr * 6144 + 2 * D;
        const float* src = lat ? src_lat : src_ctx;
        f32x4 gv[2][2];
#pragma unroll
        for (int bj = 0; bj < 2; ++bj)
#pragma unroll
            for (int n = 0; n < 2; ++n) gv[bj][n] = *(const f32x4*)(gate + col0 + bj * 128 + n * 16);
#pragma unroll
        for (int ai = 0; ai < 2; ++ai)
#pragma unroll
            for (int m = 0; m < 4; ++m) {
                const int row = row0 + ai * 128 + m * 16;
                const float* sp = src + (size_t)row * D + col0;
                float* dp = xbuf + (size_t)row * D + col0;
#pragma unroll
                for (int bj = 0; bj < 2; ++bj)
#pragma unroll
                    for (int n = 0; n < 2; ++n) { const f32x4 xi = *(const f32x4*)(sp + bj * 128 + n * 16); *(f32x4*)(dp + bj * 128 + n * 16) = ALPHA * xi + gv[bj][n] * acc[ai][bj][m][n]; }
            }
    }
};
struct EpiH {
    bf16_t* H;
    __device__ __forceinline__ void operator()(const f32x4 (&acc)[2][2][4][2], const Unit& u, int wr, int wc, int fr, int fq) const {
        const int row0 = u.r0 + wr * 64 + fr, col0 = u.pn * 128 + wc * 32 + 4 * fq;
#pragma unroll
        for (int ai = 0; ai < 2; ++ai)
#pragma unroll
            for (int m = 0; m < 4; ++m) {
                bf16_t* rowp = H + (size_t)(row0 + ai * 128 + m * 16) * DE + col0;
#pragma unroll
                for (int n = 0; n < 2; ++n) { const f32x4 a = acc[ai][0][m][n], b = acc[ai][1][m][n];
                    u32x2 w; w.x = pk2(silu_f(a[0]) * b[0], silu_f(a[1]) * b[1]); w.y = pk2(silu_f(a[2]) * b[2], silu_f(a[3]) * b[3]);
                    *(u32x2*)(rowp + n * 16) = w; }
            }
    }
};
struct EpiY {
    bf16_t* Y;
    __device__ __forceinline__ void operator()(const f32x4 (&acc)[2][2][4][2], const Unit& u, int wr, int wc, int fr, int fq) const {
        const int row0 = u.r0 + wr * 64 + fr, col0 = u.pn * 256 + wc * 32 + 4 * fq;
#pragma unroll
        for (int ai = 0; ai < 2; ++ai)
#pragma unroll
            for (int m = 0; m < 4; ++m) {
                bf16_t* rowp = Y + (size_t)(row0 + ai * 128 + m * 16) * D + col0;
#pragma unroll
                for (int bj = 0; bj < 2; ++bj)
#pragma unroll
                    for (int n = 0; n < 2; ++n) { const f32x4 a = acc[ai][bj][m][n]; u32x2 w; w.x = pk2(a[0], a[1]); w.y = pk2(a[2], a[3]); *(u32x2*)(rowp + bj * 128 + n * 16) = w; }
            }
    }
};

struct Args { const float* in[23]; float* out; unsigned char* ws; int ph_lo, ph_hi; };
typedef __attribute__((address_space(4))) const Args CArgs;
enum { I_X = 0, I_C, I_CTX, I_CCTX, I_WADA, I_BADA, I_WIN, I_CONVW, I_SINK, I_GMWS, I_GMBS, I_WOUT, I_LN1G, I_LN1B, I_WRG, I_BRG, I_WRE, I_BRE, I_W1, I_W3, I_W2, I_LN2G, I_LN2B };
constexpr int NPH = 16;

__device__ __forceinline__ void transpose_item(const float* W, int ldw, int k0, int n0, bf16_t* dst, int ldt, LAS float* scr, int lane) {
#pragma unroll 8
    for (int i = 0; i < 32; ++i) { const int kk = 2 * i + (lane >> 5); scr[kk * 33 + (lane & 31)] = W[(size_t)(k0 + kk) * ldw + n0 + (lane & 31)]; }
    LDS_WAIT(); asm volatile("" ::: "memory");
    const int c = lane & 7;
#pragma unroll
    for (int j = 0; j < 4; ++j) { const int n = (lane >> 3) + 8 * j; const LAS float* s = scr + (8 * c) * 33 + n;
        u32x4 o; o.x = pk2(s[0 * 33], s[1 * 33]); o.y = pk2(s[2 * 33], s[3 * 33]); o.z = pk2(s[4 * 33], s[5 * 33]); o.w = pk2(s[6 * 33], s[7 * 33]);
        *(u32x4*)(dst + (size_t)n * ldt + k0 + 8 * c) = o; }
    LDS_WAIT(); asm volatile("" ::: "memory");
}
__device__ __forceinline__ void convert_experts(const float* w1, const float* w3, const float* w2, bf16_t* W13T, bf16_t* W2T, int l, LAS float* scr, int gw, int NGW, int lane) {
    constexpr int I13 = NE * 16 * 16, I2 = NE * 8 * 32;
    for (int it = gw; it < 2 * I13 + I2; it += NGW) {
        if (it < 2 * I13) {
            const int which = it / I13, r = it % I13, e = r / 256, q = r % 256, kb = q / 16, nb = q % 16, n0 = nb * 32;
            const float* W = (which ? w3 : w1) + ((size_t)l * NE + e) * (size_t)D * DE;
            bf16_t* dst = W13T + ((size_t)e * 1024 + (n0 >> 7) * 256 + which * 128 + (n0 & 127)) * D;
            transpose_item(W, DE, kb * 64, n0, dst, D, scr, lane);
        } else {
            const int r = it - 2 * I13, e = r / 256, q = r % 256, kb = q / 32, nb = q % 32, n0 = nb * 32;
            const float* W = w2 + ((size_t)l * NE + e) * (size_t)DE * D;
            bf16_t* dst = W2T + ((size_t)e * 1024 + n0) * DE;
            transpose_item(W, D, kb * 64, n0, dst, DE, scr, lane);
        }
    }
}

__global__ void __launch_bounds__(512, 2) fwd_kernel(Args args) {
    extern __shared__ __attribute__((aligned(16))) unsigned char lds_raw[];
    LAS unsigned char* lds = (LAS unsigned char*)lds_raw;
    volatile LAS unsigned* MISC = (volatile LAS unsigned*)(lds + MISC_OFF);
    const int tid = threadIdx.x, lane = tid & 63, wave = __builtin_amdgcn_readfirstlane(tid >> 6);
    const int G = gridDim.x, bx = blockIdx.x;
    const int gw = bx * 8 + wave, NGW = G * 8;
#define KARGS() ({ CArgs* _kp = (CArgs*)__builtin_amdgcn_kernarg_segment_ptr(); asm volatile("" : "+s"(_kp)); _kp; })
#define PHASE_PTRS() CArgs* kp = KARGS(); unsigned char* const ws = kp->ws; int tid = threadIdx.x; asm volatile("" : "+v"(tid)); const int lane = tid & 63
#define ctl ((gu32*)(ws + WS_CTL))
#define modall ((float*)(ws + WS_MOD))
#define rope ((float*)(ws + WS_ROPE))
#define gmw ((bf16_t*)(ws + WS_GMW))
#define tokinfo ((int*)(ws + WS_TOKINFO))
#define gates ((float*)(ws + WS_GATES))
#define elist ((int*)(ws + WS_LIST))
#define WinT ((bf16_t*)(ws + WS_WIN))
#define WoutT ((bf16_t*)(ws + WS_WOUT))
#define W13T ((bf16_t*)(ws + WS_W13))
#define W2T ((bf16_t*)(ws + WS_W2))
#define hx ((bf16_t*)(ws + WS_HX))
#define xbuf ((float*)(ws + WS_XBUF))
#define proj ((bf16_t*)(ws + WS_PROJ))
#define mix ((bf16_t*)(ws + WS_MIX))
#define Hb ((bf16_t*)(ws + WS_H))
#define Yb ((bf16_t*)(ws + WS_Y))
#define mod_l (modall + (size_t)l * 9 * 6144)
#define cnt_l (ctl + CW_CNT + l * 64)
    CArgs* kp0 = KARGS();
    for (int u = tid; u < 64; u += 512) ((LAS unsigned*)(lds + MISC_OFF))[u] = 0u;
    __syncthreads();
    XcdBarrier bar; bar.bar = (unsigned*)(kp0->ws + WS_CTL) + CW_BAR; bar.x = 0; bar.st = nullptr;
    if (MK_N_LAUNCHES == 1) bar = xcd_barrier_post((unsigned*)(kp0->ws + WS_CTL) + CW_BAR, MISC + 8);
    const int lo = kp0->ph_lo, hi = kp0->ph_hi;
#ifndef PH_MASK
#define PH_MASK 0xFFFFFFFFu
#endif
#define IN(k) (((PH_MASK >> ((k) < 2 ? (k) : 2 + ((k) - 2) % 7)) & 1u) && lo <= (k) && (k) < hi)
#define GRID_BAR(k) do { if (IN(k) && IN((k) + 1)) xcd_barrier(bar); } while (0)

    if (IN(0)) {
            PHASE_PTRS();
        LAS float* cs = (LAS float*)(lds + 73728);
        LAS float* red = (LAS float*)(lds + 73728 + 36864);
        for (int i = tid; i < 9 * D; i += 512) { const int r = i >> 10, k = i & 1023; const float v = (r < 8) ? kp->in[I_C][r * D + k] : kp->in[I_CCTX][k]; cs[i] = silu_f(v); }
        __syncthreads();
        for (int item = bx; item < 2 * 96; item += G) {
            const int l = item / 96, n0 = (item % 96) * 64;
            const int kq = lane >> 4, cg = lane & 15;
            const float* wp = kp->in[I_WADA] + ((size_t)l * D + wave * 128 + kq) * 6144 + n0 + 4 * cg;
            f32x4 a[9];
#pragma unroll
            for (int r = 0; r < 9; ++r) a[r] = (f32x4){0.f, 0.f, 0.f, 0.f};
#pragma unroll 4
            for (int i = 0; i < 32; ++i) {
                const f32x4 w = *(const f32x4*)(wp + (size_t)(4 * i) * 6144);
                const int k = wave * 128 + 4 * i + kq;
#pragma unroll
                for (int r = 0; r < 9; ++r) a[r] += cs[r * D + k] * w;
            }
#pragma unroll
            for (int r = 0; r < 9; ++r)
#pragma unroll
                for (int j = 0; j < 4; ++j) { float v = a[r][j]; v += __shfl_xor(v, 16); v += __shfl_xor(v, 32); a[r][j] = v; }
            if (kq == 0) {
#pragma unroll
                for (int r = 0; r < 9; ++r)
#pragma unroll
                    for (int j = 0; j < 4; ++j) red[(wave * 9 + r) * 64 + 4 * cg + j] = a[r][j];
            }
            __syncthreads();
            for (int i = tid; i < 9 * 64; i += 512) {
                const int r = i >> 6, cidx = i & 63; float s = 0.f;
#pragma unroll
                for (int w = 0; w < 8; ++w) s += red[(w * 9 + r) * 64 + cidx];
                modall[((size_t)l * 9 + r) * 6144 + n0 + cidx] = s + kp->in[I_BADA][l * 6144 + n0 + cidx];
            }
            __syncthreads();
        }
        if (bx == G - 1) {
            for (int i = tid; i < 1024; i += 512) { const int pos = i >> 4, f = i & 15; const float fr_ = powf(10000.0f, -(float)f / 16.0f); const float ang = (float)pos * fr_; rope[i] = cosf(ang); rope[1024 + i] = sinf(ang); }
        }
        for (int i = bx * 512 + tid; i < 2 * 4 * 128 * 128; i += G * 512) gmw[i] = (bf16_t)f2bf(kp->in[I_GMWS][i]);
        LAS float* scr = (LAS float*)(lds + wave * 9216);
        {
            constexpr int IW = 16 * 64, IO = 16 * 32;
            for (int it = gw; it < 2 * IW + 2 * IO; it += NGW) {
                if (it < 2 * IW) { const int l = it / IW, q = it % IW, kb = q / 64, nb = q % 64;
                    transpose_item(kp->in[I_WIN] + (size_t)l * D * INW, INW, kb * 64, nb * 32, WinT + ((size_t)l * INW + nb * 32) * D, D, scr, lane); }
                else { const int r = it - 2 * IW, l = r / IO, q = r % IO, kb = q / 32, nb = q % 32;
                    transpose_item(kp->in[I_WOUT] + (size_t)l * D * D, D, kb * 64, nb * 32, WoutT + ((size_t)l * D + nb * 32) * D, D, scr, lane); }
            }
        }
        convert_experts(kp->in[I_W1], kp->in[I_W3], kp->in[I_W2], W13T, W2T, 0, scr, gw, NGW, lane);
    }
    GRID_BAR(0);

    if (IN(1)) {
            PHASE_PTRS();
        for (int r = gw; r < NROW; r += NGW) {
            const float* src = (r < NLAT) ? kp->in[I_X] + (size_t)r * D : kp->in[I_CTX] + (size_t)(r - NLAT) * D;
            const float* md = modall + (size_t)((r < NLAT) ? (r / SEQ) : 8) * 6144;
            u32x2* dst = (u32x2*)(hx + (size_t)r * D);
#pragma unroll
            for (int j = 0; j < 4; ++j) {
                const int c = 256 * j + 4 * lane;
                const f32x4 v = *(const f32x4*)(src + c), sh = *(const f32x4*)(md + c), sc = *(const f32x4*)(md + D + c);
                const f32x4 h = v * (1.0f + sc) + sh;
                u32x2 w; w.x = pk2(h[0], h[1]); w.y = pk2(h[2], h[3]); dst[64 * j + lane] = w;
            }
        }
    }
    GRID_BAR(1);

    for (int l = 0; l < DEPTH; ++l) {
        const int pb = 2 + 7 * l;
        const bool lastl = (l == DEPTH - 1);
        const int nrow_l = lastl ? NLAT : NROW;

        if (IN(pb + 0)) {
            PHASE_PTRS();
            SchedPlain S; S.nM = nrow_l / 256; S.nN = 8; S.nX = lastl ? (NCTX / 256) : 0; S.xpm0 = NLAT / 256; S.xpn = 2; S.G = G; S.c = bx;
            S.rowbytes = D * 2; S.Bt = (const char*)(WinT + (size_t)l * INW * D); S.btile = (size_t)256 * D * 2;
            EpiProj E{proj, rope};
            pg8::gemm_phase<EpiProj, SchedPlain>(lds, (const char*)hx, D, S, E);
        }
        GRID_BAR(pb + 0);

        if (IN(pb + 1)) {
            PHASE_PTRS();
            const int n_att = NB * 32 * 2 + (lastl ? 0 : NB * 2 * 2);
            const int n_loc = nrow_l / 128;
            for (int uidx = bx; uidx < n_att + n_loc; uidx += G) {
                if (uidx < n_att) {
                    int b, nb, g, qrow0;
                    if (uidx < NB * 64) { b = uidx >> 6; nb = (uidx >> 1) & 31; g = uidx & 1; qrow0 = b * SEQ + nb * 128; }
                    else { const int v = uidx - NB * 64; b = v >> 2; nb = -1; g = v & 1; qrow0 = NLAT + b * CTXL + ((v >> 1) & 1) * 128; }
                    const int r32 = lane & 31, hi_ = lane >> 5;
                    const int hh = 4 * g + (wave & 3), qs = 64 * (wave >> 2);
                    bf16x8 qf[2][4];
#pragma unroll
                    for (int qt = 0; qt < 2; ++qt)
#pragma unroll
                        for (int d0 = 0; d0 < 4; ++d0) qf[qt][d0] = *(const bf16x8*)(proj + (size_t)(qrow0 + qs + 32 * qt + r32) * INW + hh * 64 + 16 * d0 + 8 * hi_);
                    float mrun[2], lrun[2]; f32x16 o[2][2];
                    const float sink2 = kp->in[I_SINK][l * 8 + hh] * LOG2E;
#pragma unroll
                    for (int qt = 0; qt < 2; ++qt) { mrun[qt] = sink2; lrun[qt] = hi_ ? 0.f : 1.f;
#pragma unroll
                        for (int db = 0; db < 2; ++db)
#pragma unroll
                            for (int r = 0; r < 16; ++r) o[qt][db][r] = 0.f; }
                    LAS unsigned char* Kl = lds; LAS unsigned char* Vl = lds + 18432;
                    for (int c = 0; c < 5; ++c) {
                        int krow0, mtype = 0;
                        if (c < 3) { if (nb < 0) continue; const int kb = nb - 1 + c; if (kb < 0 || kb >= 32) continue; krow0 = b * SEQ + kb * 128; mtype = (c == 0) ? 1 : (c == 2 ? 2 : 0); }
                        else krow0 = NLAT + b * CTXL + (c - 3) * 128;
                        __syncthreads();
#pragma unroll
                        for (int i = 0; i < 2; ++i) { const int p = tid + 512 * i, row = p >> 3, c16 = p & 7;
                            const bf16_t* src = proj + (size_t)(krow0 + row) * INW + 512 + 64 * g + c16 * 8;
                            const u32x4 kv = *(const u32x4*)src, vv = *(const u32x4*)(src + 128);
                            *(LAS u32x4*)(Kl + row * 144 + c16 * 16) = kv; *(LAS u32x4*)(Vl + row * 144 + c16 * 16) = vv; }
                        __syncthreads();
#pragma unroll 1
                        for (int kvt = 0; kvt < 4; ++kvt) {
                            bf16x8 kf[4];
#pragma unroll
                            for (int d0 = 0; d0 < 4; ++d0) kf[d0] = *(const LAS bf16x8*)(Kl + (32 * kvt + r32) * 144 + (16 * d0 + 8 * hi_) * 2);
                            bf16x8 vf[2][2];
                            {
                                const int blk = (lane >> 4) & 1, qq = (lane & 15) >> 2, pp = lane & 3;
#pragma unroll
                                for (int db = 0; db < 2; ++db)
#pragma unroll
                                    for (int ks = 0; ks < 2; ++ks) {
                                        const LAS unsigned char* p0 = Vl + (32 * kvt + 16 * ks + 4 * hi_ + qq) * 144 + (32 * db + 16 * blk + 4 * pp) * 2;
                                        const s16x4 t0 = __builtin_bit_cast(s16x4, __builtin_amdgcn_ds_read_tr16_b64_v4i16((LAS s16x4*)p0));
                                        const s16x4 t1 = __builtin_bit_cast(s16x4, __builtin_amdgcn_ds_read_tr16_b64_v4i16((LAS s16x4*)(p0 + 8 * 144)));
                                        vf[db][ks] = (bf16x8){t0[0], t0[1], t0[2], t0[3], t1[0], t1[1], t1[2], t1[3]};
                                    }
                            }
#pragma unroll
                            for (int qt = 0; qt < 2; ++qt) {
                                const int i0 = qs + 32 * qt;
                                if (mtype == 1 && 32 * kvt + 31 < i0) continue;
                                if (mtype == 2 && 32 * kvt > i0 + 31) continue;
                                f32x16 s;
#pragma unroll
                                for (int r = 0; r < 16; ++r) s[r] = 0.f;
#pragma unroll
                                for (int d0 = 0; d0 < 4; ++d0) s = __builtin_amdgcn_mfma_f32_32x32x16_bf16(kf[d0], qf[qt][d0], s, 0, 0, 0);
                                const int iq = i0 + r32;
                                if (mtype != 0) {
#pragma unroll
                                    for (int r = 0; r < 16; ++r) { const int jj = 32 * kvt + (r & 3) + 8 * (r >> 2) + 4 * hi_;
                                        const bool ok = (mtype == 1) ? (jj >= iq) : (jj <= iq); s[r] = ok ? s[r] : -INFINITY; }
                                }
                                float tmax = s[0];
#pragma unroll
                                for (int r = 1; r < 16; ++r) tmax = fmaxf(tmax, s[r]);
                                tmax = fmaxf(tmax, __shfl_xor(tmax, 32));
                                const float mnew = fmaxf(mrun[qt], tmax);
                                const float scl = __builtin_amdgcn_exp2f(mrun[qt] - mnew);
                                mrun[qt] = mnew;
                                float psum = 0.f;
#pragma unroll
                                for (int r = 0; r < 16; ++r) { s[r] = __builtin_amdgcn_exp2f(s[r] - mnew); psum += s[r]; }
                                lrun[qt] = lrun[qt] * scl + psum;
#pragma unroll
                                for (int db = 0; db < 2; ++db)
#pragma unroll
                                    for (int r = 0; r < 16; ++r) o[qt][db][r] *= scl;
                                bf16x8 pf[2];
#pragma unroll
                                for (int ks = 0; ks < 2; ++ks) { u32x4 w; w.x = pk2(s[8 * ks + 0], s[8 * ks + 1]); w.y = pk2(s[8 * ks + 2], s[8 * ks + 3]); w.z = pk2(s[8 * ks + 4], s[8 * ks + 5]); w.w = pk2(s[8 * ks + 6], s[8 * ks + 7]); pf[ks] = __builtin_bit_cast(bf16x8, w); }
#pragma unroll
                                for (int db = 0; db < 2; ++db)
#pragma unroll
                                    for (int ks = 0; ks < 2; ++ks) o[qt][db] = __builtin_amdgcn_mfma_f32_32x32x16_bf16(vf[db][ks], pf[ks], o[qt][db], 0, 0, 0);
                            }
                        }
                    }
#pragma unroll
                    for (int qt = 0; qt < 2; ++qt) {
                        float lt = lrun[qt]; lt += __shfl_xor(lt, 32);
                        const float inv = 1.0f / lt;
                        bf16_t* orow = mix + (size_t)(qrow0 + qs + 32 * qt + r32) * D + hh * 64;
#pragma unroll
                        for (int db = 0; db < 2; ++db)
#pragma unroll
                            for (int rg = 0; rg < 4; ++rg) { u32x2 w; w.x = pk2(o[qt][db][4 * rg + 0] * inv, o[qt][db][4 * rg + 1] * inv); w.y = pk2(o[qt][db][4 * rg + 2] * inv, o[qt][db][4 * rg + 3] * inv);
                                *(u32x2*)(orow + 32 * db + 8 * rg + 4 * hi_) = w; }
                    }
                    __syncthreads();
                } else {
                    const int ch = uidx - n_att, row0 = ch * 128;
                    const int seqlen = (row0 < NLAT) ? SEQ : CTXL;
                    const int sbase = (row0 < NLAT) ? (row0 / SEQ) * SEQ : NLAT + ((row0 - NLAT) / CTXL) * CTXL;
                    {
                        const int c8 = (tid & 31) * 8, tg = tid >> 5;
                        float w0[8], w1[8], w2[8];
                        const float* cw = kp->in[I_CONVW] + (size_t)l * 3 * 256;
#pragma unroll
                        for (int j = 0; j < 8; ++j) { w0[j] = cw[c8 + j]; w1[j] = cw[256 + c8 + j]; w2[j] = cw[512 + c8 + j]; }
                        float zp[8], zc[8], zn[8];
                        auto loadz = [&](int row, float (&z)[8]) {
                            if (row < sbase || row >= sbase + seqlen) {
#pragma unroll
                                for (int j = 0; j < 8; ++j) z[j] = 0.f;
                            } else {
                                const u32x4 cc = *(const u32x4*)(proj + (size_t)row * INW + 1024 + c8), cx = *(const u32x4*)(proj + (size_t)row * INW + 1280 + c8);
                                z[0] = bflo(cc.x) * bflo(cx.x); z[1] = bfhi(cc.x) * bfhi(cx.x); z[2] = bflo(cc.y) * bflo(cx.y); z[3] = bfhi(cc.y) * bfhi(cx.y);
                                z[4] = bflo(cc.z) * bflo(cx.z); z[5] = bfhi(cc.z) * bfhi(cx.z); z[6] = bflo(cc.w) * bflo(cx.w); z[7] = bfhi(cc.w) * bfhi(cx.w);
                            }
                        };
                        const int t0 = row0 + tg * 8;
                        loadz(t0 - 1, zp); loadz(t0, zc);
#pragma unroll 1
                        for (int tt = 0; tt < 8; ++tt) {
                            const int row = t0 + tt;
                            loadz(row + 1, zn);
                            const u32x4 cb = *(const u32x4*)(proj + (size_t)row * INW + 768 + c8);
                            float bb[8] = {bflo(cb.x), bfhi(cb.x), bflo(cb.y), bfhi(cb.y), bflo(cb.z), bfhi(cb.z), bflo(cb.w), bfhi(cb.w)};
                            float y[8];
#pragma unroll
                            for (int j = 0; j < 8; ++j) y[j] = bb[j] * (zp[j] * w0[j] + zc[j] * w1[j] + zn[j] * w2[j]);
                            u32x4 ov; ov.x = pk2(y[0], y[1]); ov.y = pk2(y[2], y[3]); ov.z = pk2(y[4], y[5]); ov.w = pk2(y[6], y[7]);
                            *(u32x4*)(mix + (size_t)row * D + 512 + c8) = ov;
#pragma unroll
                            for (int j = 0; j < 8; ++j) { zp[j] = zc[j]; zc[j] = zn[j]; }
                        }
                    }
                    __syncthreads();
                    LAS unsigned char* Vg = lds;
                    for (int tt = wave; tt < 128; tt += 8) {
                        const int row = row0 + tt;
                        const u32x2 gvv = *(const u32x2*)(proj + (size_t)row * INW + 1792 + 4 * lane);
                        float v0 = gelu_tanh_f(bflo(gvv.x)), v1 = gelu_tanh_f(bfhi(gvv.x)), v2 = gelu_tanh_f(bflo(gvv.y)), v3 = gelu_tanh_f(bfhi(gvv.y));
                        const float mu = wave_sum((v0 + v1) + (v2 + v3)) * (1.0f / 256.0f);
                        v0 -= mu; v1 -= mu; v2 -= mu; v3 -= mu;
                        const float var = wave_sum((v0 * v0 + v1 * v1) + (v2 * v2 + v3 * v3)) * (1.0f / 256.0f);
                        const float rs = 1.0f / sqrtf(var + LN_EPS);
                        u32x2 w; w.x = pk2(v0 * rs, v1 * rs); w.y = pk2(v2 * rs, v3 * rs);
                        *(LAS u32x2*)(Vg + tt * 528 + lane * 8) = w;
                    }
                    __syncthreads();
                    {
                        const int gg = wave >> 1, ph = wave & 1, r32 = lane & 31, hi_ = lane >> 5;
                        const int blk = (lane >> 4) & 1, qq = (lane & 15) >> 2, pp = lane & 3;
                        const bf16_t* wsg = gmw + ((size_t)(l * 4 + gg) * 128) * 128;
                        f32x16 sacc[2][2];
#pragma unroll
                        for (int pt = 0; pt < 2; ++pt)
#pragma unroll
                            for (int ct = 0; ct < 2; ++ct)
#pragma unroll
                                for (int r = 0; r < 16; ++r) sacc[pt][ct][r] = 0.f;
#pragma unroll 2
                        for (int ks = 0; ks < 8; ++ks) {
                            bf16x8 af[2], bfr[2];
#pragma unroll
                            for (int ct = 0; ct < 2; ++ct) {
                                const LAS unsigned char* p0 = Vg + (16 * ks + 8 * hi_ + qq) * 528 + (gg * 64 + 32 * ct + 16 * blk + 4 * pp) * 2;
                                const s16x4 t0 = __builtin_bit_cast(s16x4, __builtin_amdgcn_ds_read_tr16_b64_v4i16((LAS s16x4*)p0));
                                const s16x4 t1 = __builtin_bit_cast(s16x4, __builtin_amdgcn_ds_read_tr16_b64_v4i16((LAS s16x4*)(p0 + 4 * 528)));
                                af[ct] = (bf16x8){t0[0], t0[1], t0[2], t0[3], t1[0], t1[1], t1[2], t1[3]};
                            }
#pragma unroll
                            for (int pt = 0; pt < 2; ++pt) bfr[pt] = *(const bf16x8*)(wsg + (size_t)(64 * ph + 32 * pt + r32) * 128 + 16 * ks + 8 * hi_);
#pragma unroll
                            for (int pt = 0; pt < 2; ++pt)
#pragma unroll
                                for (int ct = 0; ct < 2; ++ct) sacc[pt][ct] = __builtin_amdgcn_mfma_f32_32x32x16_bf16(af[ct], bfr[pt], sacc[pt][ct], 0, 0, 0);
                        }
#pragma unroll
                        for (int pt = 0; pt < 2; ++pt) {
                            const int p = 64 * ph + 32 * pt + r32, row = row0 + p;
                            const float bias = kp->in[I_GMBS][(l * 4 + gg) * 128 + p];
#pragma unroll
                            for (int ct = 0; ct < 2; ++ct)
#pragma unroll
                                for (int rg = 0; rg < 4; ++rg) {
                                    const int cc = gg * 64 + 32 * ct + 8 * rg + 4 * hi_;
                                    const u32x2 uu = *(const u32x2*)(proj + (size_t)row * INW + 1536 + cc);
                                    const float y0 = gelu_tanh_f(bflo(uu.x)) * (sacc[pt][ct][4 * rg + 0] + bias), y1 = gelu_tanh_f(bfhi(uu.x)) * (sacc[pt][ct][4 * rg + 1] + bias);
                                    const float y2 = gelu_tanh_f(bflo(uu.y)) * (sacc[pt][ct][4 * rg + 2] + bias), y3 = gelu_tanh_f(bfhi(uu.y)) * (sacc[pt][ct][4 * rg + 3] + bias);
                                    u32x2 w; w.x = pk2(y0, y1); w.y = pk2(y2, y3);
                                    *(u32x2*)(mix + (size_t)row * D + 768 + cc) = w;
                                }
                        }
                    }
                    __syncthreads();
                }
            }
        }
        GRID_BAR(pb + 1);

        if (IN(pb + 2)) {
            PHASE_PTRS();
            SchedPlain S; S.nM = nrow_l / 256; S.nN = 4; S.nX = 0; S.xpm0 = 0; S.xpn = 0; S.G = G; S.c = bx;
            S.rowbytes = D * 2; S.Bt = (const char*)(WoutT + (size_t)l * D * D); S.btile = (size_t)256 * D * 2;
            const float* s_lat = xbuf; const float* s_ctx = xbuf; if (l == 0) { s_lat = kp->in[I_X]; s_ctx = kp->in[I_CTX] - (size_t)NLAT * D; }
            EpiOut E{xbuf, s_lat, s_ctx, mod_l};
            pg8::gemm_phase<EpiOut, SchedPlain>(lds, (const char*)mix, D, S, E);
        }
        GRID_BAR(pb + 2);

        if (IN(pb + 3)) {
            PHASE_PTRS();
            LAS float* WrT = (LAS float*)lds;
            for (int i = tid; i < 36 * D; i += 512) {
                const int k = i / 36, o_ = i % 36;
                const float v = (o_ < 4) ? kp->in[I_WRG][((size_t)l * D + k) * 4 + o_] : kp->in[I_WRE][((size_t)l * D + k) * 32 + (o_ - 4)];
                WrT[o_ * D + k] = v;
            }
            LAS int* lcnt = (LAS int*)(lds + L_N1);
            LAS int* lbase = lcnt + 32;
            LAS int* rec = lbase + 32;
            const int RB = lastl ? 128 : 136;
            const int nblk = nrow_l / RB;
            const float* g1v = kp->in[I_LN1G] + l * D; const float* b1v = kp->in[I_LN1B] + l * D;
            for (int rb = bx; rb < nblk; rb += G) {
                if (tid < 32) lcnt[tid] = 0;
                __syncthreads();
                for (int rr = wave; rr < RB; rr += 8) {
                    const int row = rb * RB + rr;
                    float* xr = xbuf + (size_t)row * D;
                    const float* md = mod_l + (size_t)((row < NLAT) ? (row / SEQ) : 8) * 6144;
                    f32x4 v[4]; float s = 0.f;
#pragma unroll
                    for (int j = 0; j < 4; ++j) { v[j] = *(const f32x4*)(xr + 256 * j + 4 * lane); s += (v[j][0] + v[j][1]) + (v[j][2] + v[j][3]); }
                    const float mean = wave_sum(s) * (1.0f / D); float s2 = 0.f;
#pragma unroll
                    for (int j = 0; j < 4; ++j) { v[j] = v[j] - mean; s2 += (v[j][0] * v[j][0] + v[j][1] * v[j][1]) + (v[j][2] * v[j][2] + v[j][3] * v[j][3]); }
                    const float rstd = 1.0f / sqrtf(wave_sum(s2) * (1.0f / D) + LN_EPS);
                    f32x4 h[4];
#pragma unroll
                    for (int j = 0; j < 4; ++j) {
                        const int c = 256 * j + 4 * lane;
                        const f32x4 gg = *(const f32x4*)(g1v + c), bb = *(const f32x4*)(b1v + c);
                        const f32x4 x1 = v[j] * rstd * gg + bb;
                        *(f32x4*)(xr + c) = x1;
                        const f32x4 sh = *(const f32x4*)(md + 3 * D + c), sc = *(const f32x4*)(md + 4 * D + c);
                        h[j] = x1 * (1.0f + sc) + sh;
                        u32x2 w; w.x = pk2(h[j][0], h[j][1]); w.y = pk2(h[j][2], h[j][3]);
                        *(u32x2*)(hx + (size_t)row * D + c) = w;
                    }
                    float lg[36];
#pragma unroll
                    for (int o_ = 0; o_ < 36; ++o_) {
                        float a = 0.f;
#pragma unroll
                        for (int j = 0; j < 4; ++j) { const f32x4 w = *(const LAS f32x4*)(WrT + o_ * D + 256 * j + 4 * lane); a += (h[j][0] * w[0] + h[j][1] * w[1]) + (h[j][2] * w[2] + h[j][3] * w[3]); }
                        lg[o_] = wave_sum(a);
                    }
                    float gl[4];
#pragma unroll
                    for (int j = 0; j < 4; ++j) gl[j] = lg[j] + kp->in[I_BRG][l * 4 + j];
                    int gi = 0; float gm = gl[0];
#pragma unroll
                    for (int j = 1; j < 4; ++j) if (gl[j] > gm) { gm = gl[j]; gi = j; }
                    float gsum = 0.f;
#pragma unroll
                    for (int j = 0; j < 4; ++j) gsum += expf(gl[j] - gm);
                    const float pgrp = 1.0f / gsum;
                    float el[8];
#pragma unroll
                    for (int j = 0; j < 8; ++j) {
                        float vsel = lg[4 + j];
#pragma unroll
                        for (int q = 1; q < 4; ++q) vsel = (gi == q) ? lg[4 + 8 * q + j] : vsel;
                        el[j] = vsel + kp->in[I_BRE][l * 32 + gi * 8 + j];
                    }
                    int i1 = 0; float e1 = el[0];
#pragma unroll
                    for (int j = 1; j < 8; ++j) if (el[j] > e1) { e1 = el[j]; i1 = j; }
                    int i2 = -1; float e2 = -INFINITY;
#pragma unroll
                    for (int j = 0; j < 8; ++j) if (j != i1 && el[j] > e2) { e2 = el[j]; i2 = j; }
                    const float ex = expf(e2 - e1);
                    const float ga = pgrp / (1.0f + ex), gb = pgrp * ex / (1.0f + ex);
                    if (lane == 0) {
                        const int ea = gi * 8 + i1, eb = gi * 8 + i2;
                        const int ra = atomicAdd((int*)&lcnt[ea], 1), rb2 = atomicAdd((int*)&lcnt[eb], 1);
                        rec[rr * 4 + 0] = ea; rec[rr * 4 + 1] = ra; rec[rr * 4 + 2] = eb; rec[rr * 4 + 3] = rb2;
                        *(f32x2*)(gates + (size_t)row * 2) = (f32x2){ga, gb};
                    }
                }
                __syncthreads();
                if (tid < 32) lbase[tid] = (int)__hip_atomic_fetch_add(cnt_l + tid, (unsigned)lcnt[tid], __ATOMIC_RELAXED, __HIP_MEMORY_SCOPE_AGENT);
                __syncthreads();
                if (tid < RB) {
                    const int row = rb * RB + tid;
                    const int ea = rec[tid * 4 + 0], ra = lbase[ea] + rec[tid * 4 + 1], eb = rec[tid * 4 + 2], rb2 = lbase[eb] + rec[tid * 4 + 3];
                    elist[(size_t)ea * NROW + ra] = row; elist[(size_t)eb * NROW + rb2] = row;
                    *(int4*)(tokinfo + (size_t)row * 4) = make_int4(ea, ra, eb, rb2);
                }
                __syncthreads();
            }
        }
        GRID_BAR(pb + 3);

        LAS int* tile_e = (LAS int*)(lds + L_TILE_E); LAS int* tile_r0 = (LAS int*)(lds + L_TILE_R0); LAS int* tile_j = (LAS int*)(lds + L_TILE_J);
        LAS int* pstart = (LAS int*)(lds + L_PSTART); LAS int* ecnt = (LAS int*)(lds + L_CNT); LAS int* ntile_p = (LAS int*)(lds + L_NT);
        if (IN(pb + 4) || IN(pb + 5) || IN(pb + 6)) {
            PHASE_PTRS();
            __syncthreads();
            if (tid < 64) {
                const int e = tid & 31;
                const int c = (int)__hip_atomic_load(cnt_l + e, __ATOMIC_RELAXED, __HIP_MEMORY_SCOPE_AGENT);
                const int nt_ = (c + 255) >> 8;
                int inc = nt_;
#pragma unroll
                for (int o = 1; o < 32; o <<= 1) { const int v = __shfl_up(inc, o, 32); if (e >= o) inc += v; }
                const int tb = inc - nt_;
                if (tid < 32) {
                    ecnt[e] = c; pstart[e] = tb * 256;
#pragma nounroll
                    for (int j = 0; j < nt_; ++j) { tile_e[tb + j] = e; tile_r0[tb + j] = (tb + j) * 256; tile_j[tb + j] = j; }
                    if (e == 31) ntile_p[0] = inc;
                }
            }
            __syncthreads();
        }

        if (IN(pb + 4)) {
            PHASE_PTRS();
            const int ntile = __builtin_amdgcn_readfirstlane(ntile_p[0]);
            LAS int* idx = (LAS int*)(lds + L_IDX);
            for (int i = 0; i < 8; ++i) {
                const int L = i * G + bx; if (L >= 4 * ntile) break;
                const int t = L >> 2, e = tile_e[t], j = tile_j[t], ce = ecnt[e];
                if (tid < 256) { const int rr = j * 256 + tid; const int tok = elist[(size_t)e * NROW + (rr < ce ? rr : 0)]; idx[i * 256 + tid] = tok * (D * 2); }
            }
            __syncthreads();
            SchedMoe<true> S; S.ntile = ntile; S.G = G; S.c = bx; S.rowbytes = D * 2; S.Bt = (const char*)W13T; S.btile = (size_t)256 * D * 2; S.bexp = (size_t)1024 * D * 2;
            S.tile_e = tile_e; S.tile_r0 = tile_r0; S.idx = idx;
            EpiH E{Hb};
            pg8::gemm_phase<EpiH, SchedMoe<true>>(lds, (const char*)hx, D, S, E);
        }
        GRID_BAR(pb + 4);

        if (IN(pb + 5)) {
            PHASE_PTRS();
            const int ntile = __builtin_amdgcn_readfirstlane(ntile_p[0]);
            SchedMoe<false> S; S.ntile = ntile; S.G = G; S.c = bx; S.rowbytes = DE * 2; S.Bt = (const char*)W2T; S.btile = (size_t)256 * DE * 2; S.bexp = (size_t)1024 * DE * 2;
            S.tile_e = tile_e; S.tile_r0 = tile_r0; S.idx = nullptr;
            EpiY E{Yb};
            pg8::gemm_phase<EpiY, SchedMoe<false>>(lds, (const char*)Hb, DE, S, E);
        }
        GRID_BAR(pb + 5);

        if (IN(pb + 6)) {
            PHASE_PTRS();
            const float* g2v = kp->in[I_LN2G] + l * D; const float* b2v = kp->in[I_LN2B] + l * D;
            const float* mod_n = modall + (size_t)(l + 1) * 9 * 6144;
            for (int row = gw; row < nrow_l; row += NGW) {
                const int mr = (row < NLAT) ? (row / SEQ) : 8;
                const float* md = mod_l + (size_t)mr * 6144;
                const int4 ti = *(const int4*)(tokinfo + (size_t)row * 4);
                const f32x2 gt = *(const f32x2*)(gates + (size_t)row * 2);
                const bf16_t* ya = Yb + (size_t)(pstart[ti.x] + ti.y) * D; const bf16_t* yb = Yb + (size_t)(pstart[ti.z] + ti.w) * D;
                const float* xr = xbuf + (size_t)row * D;
                f32x4 v[4]; float s = 0.f;
#pragma unroll
                for (int j = 0; j < 4; ++j) {
                    const int c = 256 * j + 4 * lane;
                    const f32x4 x1 = *(const f32x4*)(xr + c), g2 = *(const f32x4*)(md + 5 * D + c);
                    const u32x2 a = *(const u32x2*)(ya + c), b = *(const u32x2*)(yb + c);
                    f32x4 y; y[0] = gt[0] * bflo(a.x) + gt[1] * bflo(b.x); y[1] = gt[0] * bfhi(a.x) + gt[1] * bfhi(b.x); y[2] = gt[0] * bflo(a.y) + gt[1] * bflo(b.y); y[3] = gt[0] * bfhi(a.y) + gt[1] * bfhi(b.y);
                    v[j] = ALPHA * x1 + g2 * y;
                    s += (v[j][0] + v[j][1]) + (v[j][2] + v[j][3]);
                }
                const float mean = wave_sum(s) * (1.0f / D); float s2 = 0.f;
#pragma unroll
                for (int j = 0; j < 4; ++j) { v[j] = v[j] - mean; s2 += (v[j][0] * v[j][0] + v[j][1] * v[j][1]) + (v[j][2] * v[j][2] + v[j][3] * v[j][3]); }
                const float rstd = 1.0f / sqrtf(wave_sum(s2) * (1.0f / D) + LN_EPS);
                float* dst = lastl ? (kp->out + (size_t)row * D) : (xbuf + (size_t)row * D);
#pragma unroll
                for (int j = 0; j < 4; ++j) {
                    const int c = 256 * j + 4 * lane;
                    const f32x4 gg = *(const f32x4*)(g2v + c), bb = *(const f32x4*)(b2v + c);
                    const f32x4 x2 = v[j] * rstd * gg + bb;
                    *(f32x4*)(dst + c) = x2;
                    if (!lastl) {
                        const f32x4 sh = *(const f32x4*)(mod_n + (size_t)mr * 6144 + c), sc = *(const f32x4*)(mod_n + (size_t)mr * 6144 + D + c);
                        const f32x4 hn = x2 * (1.0f + sc) + sh;
                        u32x2 w; w.x = pk2(hn[0], hn[1]); w.y = pk2(hn[2], hn[3]);
                        *(u32x2*)(hx + (size_t)row * D + c) = w;
                    }
                }
            }
            if (!lastl) {
                __syncthreads();
                LAS float* scr = (LAS float*)(lds + wave * 9216);
                convert_experts(kp->in[I_W1], kp->in[I_W3], kp->in[I_W2], W13T, W2T, l + 1, scr, gw, NGW, lane);
            }
        }
        if (!lastl) GRID_BAR(pb + 6);
    }
#undef IN
#undef GRID_BAR
}

extern "C" void kernel_launch(void* const* d_in, const int* in_sizes, int n_in, void* d_out, int out_size, void* d_ws, size_t ws_size, hipStream_t stream) {
    static int grid = 0;
    if (grid == 0) {
        if (n_in != 23 || out_size != NLAT * D || ws_size < WS_END) { fprintf(stderr, "kernel_launch: unexpected shapes (n_in %d out %d ws %zu)\n", n_in, out_size, ws_size); grid = -1; return; }
        int dev = 0, cus = 0, per_cu = 0;
        if (hipGetDevice(&dev) != hipSuccess || hipDeviceGetAttribute(&cus, hipDeviceAttributeMultiprocessorCount, dev) != hipSuccess) { grid = -1; return; }
        if (hipFuncSetAttribute((const void*)fwd_kernel, hipFuncAttributeMaxDynamicSharedMemorySize, LDS_BYTES) != hipSuccess) { fprintf(stderr, "kernel_launch: hipFuncSetAttribute failed\n"); grid = -1; return; }
        if (hipOccupancyMaxActiveBlocksPerMultiprocessor(&per_cu, (const void*)fwd_kernel, 512, LDS_BYTES) != hipSuccess || per_cu < 1) { fprintf(stderr, "kernel_launch: occupancy query says %d\n", per_cu); }
        (void)hipGetLastError();
        grid = cus;
    }
    if (grid < 0) return;
    if (hipMemsetAsync((char*)d_ws + WS_CTL, 0, CTL_ZERO_BYTES, stream) != hipSuccess) return;
    Args a{};
    for (int i = 0; i < 23; ++i) a.in[i] = (const float*)d_in[i];
    a.out = (float*)d_out; a.ws = (unsigned char*)d_ws;
#if MK_N_LAUNCHES == 1
    a.ph_lo = 0; a.ph_hi = NPH;
    hipLaunchKernelGGL(fwd_kernel, dim3(grid), dim3(512), LDS_BYTES, stream, a);
#else
    for (int p = 0; p < NPH; ++p) { a.ph_lo = p; a.ph_hi = p + 1; hipLaunchKernelGGL(fwd_kernel, dim3(grid), dim3(512), LDS_BYTES, stream, a); }
#endif
}
```

```cpp
#include <hip/hip_runtime.h>
#include <cstdio>
#include <cstdint>

#ifndef MK_N_LAUNCHES
#define MK_N_LAUNCHES 1
#endif

#define LAS __attribute__((address_space(3)))
#define GAS __attribute__((address_space(1)))
typedef unsigned short bf16_t;
typedef short bf16x8 __attribute__((ext_vector_type(8)));
typedef short s16x4 __attribute__((ext_vector_type(4)));
typedef float f32x2 __attribute__((ext_vector_type(2)));
typedef float f32x4 __attribute__((ext_vector_type(4)));
typedef float f32x16 __attribute__((ext_vector_type(16)));
typedef unsigned u32x2 __attribute__((ext_vector_type(2)));
typedef unsigned u32x4 __attribute__((ext_vector_type(4)));
typedef GAS unsigned gu32;

constexpr int D = 1024, NB = 8, SEQ = 4096, CTXL = 256, DEPTH = 2;
constexpr int NLAT = NB * SEQ, NCTX = NB * CTXL, NROW = NLAT + NCTX;
constexpr int INW = 2048, NE = 32, DE = 512;
constexpr int MAXSLOT = 77824;
constexpr float ALPHA = 1.4142135623730951f;
constexpr float LN_EPS = 1e-6f;
constexpr float LOG2E = 1.4426950408889634f;
constexpr float QSCALE = 0.125f * LOG2E;

constexpr size_t MiB = 1u << 20;
constexpr size_t WS_CTL = 0, CTL_ZERO_BYTES = 64 * 1024;
constexpr size_t WS_MOD = 1 * MiB;
constexpr size_t WS_ROPE = 1 * MiB + 512 * 1024;
constexpr size_t WS_GMW = 1 * MiB + 768 * 1024;
constexpr size_t WS_TOKINFO = 2 * MiB;
constexpr size_t WS_GATES = 3 * MiB;
constexpr size_t WS_WRIMG = 3 * MiB + 512 * 1024;
constexpr size_t WS_LIST = 4 * MiB;
constexpr size_t WS_PSTAT = 550 * MiB;
constexpr size_t WS_RSTAT = 559 * MiB;
constexpr size_t WS_GC = 560 * MiB;
constexpr size_t WS_WIN = 10 * MiB;
constexpr size_t WS_WOUT = 18 * MiB;
constexpr size_t WS_W13 = 22 * MiB;
constexpr size_t WS_W2 = 86 * MiB;
constexpr size_t WS_HX = 118 * MiB;
constexpr size_t WS_XBUF = 186 * MiB;
constexpr size_t WS_PROJ = 322 * MiB;
constexpr size_t WS_MIX = 458 * MiB;
constexpr size_t WS_H = 322 * MiB;
constexpr size_t WS_Y = 398 * MiB;
constexpr size_t WS_END = 561 * MiB;
static_assert(WS_H + (size_t)MAXSLOT * DE * 2 <= WS_Y && WS_Y + (size_t)MAXSLOT * D * 2 <= WS_PSTAT && WS_PSTAT + (size_t)NROW * 256 <= WS_RSTAT, "ws map");
static_assert(WS_PROJ + (size_t)NROW * INW * 2 <= WS_MIX && WS_MIX + (size_t)NROW * D * 2 <= WS_PSTAT, "ws map");
static_assert(WS_LIST + (size_t)NE * NROW * 4 <= WS_WIN, "ws map");
constexpr int CW_BAR = 4096;
constexpr int CW_CNT = 8192;
constexpr int CW_Q = 8448;
constexpr int CW_DEP = 8704;
constexpr int CW_TMO = 0;
static_assert((CW_Q + 2 * 64) * 4 <= (int)CTL_ZERO_BYTES && (CW_BAR + 3456) * 4 <= (int)CTL_ZERO_BYTES, "control words inside the per-call memset");

constexpr int LDS_BYTES = 163840;
constexpr int RING_BYTES = 131072;
constexpr int L_TILE_E = 131072, L_TILE_R0 = L_TILE_E + 1280, L_TILE_J = L_TILE_R0 + 1280, L_PSTART = L_TILE_J + 1280, L_CNT = L_PSTART + 128, L_NT = L_CNT + 128;
constexpr int L_ROPE = 131072;
constexpr int L_IDX = 131072 + 8192;
constexpr int WR_RS = 2064, WR_LO = 36 * WR_RS, WRIMG_BYTES = 2 * WR_LO;
constexpr int L_N1 = 149504;
constexpr int MISC_OFF = LDS_BYTES - 256;

typedef __bf16 bf16x2_t __attribute__((ext_vector_type(2)));
__device__ __forceinline__ unsigned pk2(float lo, float hi) { f32x2 v = {lo, hi}; const bf16x2_t b = __builtin_convertvector(v, bf16x2_t); return __builtin_bit_cast(unsigned, b); }
__device__ __forceinline__ unsigned f2bf(float f) { return pk2(f, 0.f) & 0xffffu; }
constexpr float W8_SCALE = 64.0f, H8_SCALE = 8.0f, Y8_SCALE = 64.0f;
__device__ __forceinline__ float clamp8(float x) { return fminf(fmaxf(x, -448.0f), 448.0f); }
__device__ __forceinline__ unsigned pk4_fp8(float a, float b, float c, float d) {
    int w = __builtin_amdgcn_cvt_pk_fp8_f32(clamp8(a), clamp8(b), 0, false); w = __builtin_amdgcn_cvt_pk_fp8_f32(clamp8(c), clamp8(d), w, true); return (unsigned)w; }
__device__ __forceinline__ float bf2f(unsigned short b) { return __builtin_bit_cast(float, ((unsigned)b) << 16); }
__device__ __forceinline__ float bflo(unsigned w) { return __builtin_bit_cast(float, w << 16); }
__device__ __forceinline__ float bfhi(unsigned w) { return __builtin_bit_cast(float, w & 0xffff0000u); }
__device__ __forceinline__ float wave_sum(float v) {
#pragma unroll
    for (int o = 1; o < 64; o <<= 1) v += __shfl_xor(v, o);
    return v;
}
__device__ __forceinline__ float silu_f(float x) { return x * __builtin_amdgcn_rcpf(1.0f + __expf(-x)); }
__device__ __forceinline__ float gelu_tanh_f(float x) {
    const float z2 = 1.5957691216057308f * (x + 0.044715f * x * x * x);
    return x * __builtin_amdgcn_rcpf(1.0f + __expf(-z2));
}
#define LDS_WAIT() asm volatile("s_waitcnt lgkmcnt(0)" ::: "memory")
#define VM_WAIT() asm volatile("s_waitcnt vmcnt(0)" ::: "memory")

#define XB_TMO      128
#define XB_XCNT(j)  (256  + 64 * (j))
#define XB_XSUB(j)  (1280 + 64 * (j))
#define XB_XGEN(j)  (2304 + 64 * (j))
#define XB_TOP      3328
#define XB_TOPGEN   3392
#define XCD_BAR_WORDS 3456
#define XB_SPIN_CAP (1u << 18)
__device__ __forceinline__ unsigned xb_ld(unsigned* p)              { return __hip_atomic_load(p, __ATOMIC_RELAXED, __HIP_MEMORY_SCOPE_AGENT); }
__device__ __forceinline__ unsigned xb_add(unsigned* p, unsigned v) { return __hip_atomic_fetch_add(p, v, __ATOMIC_RELAXED, __HIP_MEMORY_SCOPE_AGENT); }
__device__ __forceinline__ unsigned xb_xcc_id() { return (unsigned)__builtin_amdgcn_s_getreg((3 << 11) | 20) & 0xFu; }
#define XB_SPIN(cond, bar) do { unsigned _sp = 0; while (cond) { __builtin_amdgcn_s_sleep(1); \
    if ((++_sp & 255u) == 0u) { if (xb_ld(&(bar)[XB_TMO])) break; if (_sp > XB_SPIN_CAP) { atomicAdd(&(bar)[XB_TMO], 1u); break; } } } } while (0)
struct XcdBarrier { unsigned* bar; unsigned x; volatile LAS unsigned* st; };
__device__ __forceinline__ XcdBarrier xcd_barrier_post(unsigned* bar, volatile LAS unsigned* st) {
    XcdBarrier b; b.bar = bar; b.x = xb_xcc_id(); b.st = st;
    if (threadIdx.x == 0) (void)xb_add(&bar[XB_XCNT(b.x)], 1u);
    return b;
}
__device__ __forceinline__ void xcd_barrier_complete(unsigned* bar, unsigned x, unsigned& nloc, unsigned& nx) {
    const unsigned G = gridDim.x * gridDim.y * gridDim.z;
    unsigned sum, cnt, mine, sp = 0u;
    for (;;) {
        sum = 0u; cnt = 0u; mine = 0u;
#pragma unroll
        for (unsigned j = 0; j < 16; ++j) { const unsigned c = xb_ld(&bar[XB_XCNT(j)]); sum += c; cnt += (c > 0u) ? 1u : 0u; mine = (j == x) ? c : mine; }
        if (sum == G) break;
        __builtin_amdgcn_s_sleep(1);
        if ((++sp & 255u) == 0u) { if (xb_ld(&bar[XB_TMO])) break; if (sp > XB_SPIN_CAP) { atomicAdd(&bar[XB_TMO], 1u); break; } }
    }
    nloc = mine > 0u ? mine : 1u; nx = cnt > 0u ? cnt : 1u;
}
__device__ __forceinline__ void xcd_barrier(const XcdBarrier& b) {
    asm volatile("s_waitcnt vmcnt(0)" ::: "memory");
    __syncthreads();
    if (threadIdx.x == 0) {
        unsigned* bar = b.bar;
        __builtin_amdgcn_s_waitcnt(0);
        unsigned nloc = b.st[0], nx = b.st[1];
        if (nloc == 0u) { xcd_barrier_complete(bar, b.x, nloc, nx); b.st[0] = nloc; b.st[1] = nx; }
        const unsigned old = xb_add(&bar[XB_XSUB(b.x)], 1u);
        const unsigned gen = old / nloc;
        if (old + 1u == (gen + 1u) * nloc) {
            __builtin_amdgcn_fence(__ATOMIC_RELEASE, "agent");
            asm volatile("s_waitcnt vmcnt(0)" ::: "memory");
            const unsigned og = xb_add(&bar[XB_TOP], 1u);
            const unsigned tg = og / nx;
            if (og + 1u == (tg + 1u) * nx) xb_add(&bar[XB_TOPGEN], 1u);
            else XB_SPIN(xb_ld(&bar[XB_TOPGEN]) == tg, bar);
            __builtin_amdgcn_fence(__ATOMIC_ACQUIRE, "agent");
            xb_add(&bar[XB_XGEN(b.x)], 1u);
            asm volatile("s_waitcnt vmcnt(0)" ::: "memory");
        } else {
            XB_SPIN(xb_ld(&bar[XB_XGEN(b.x)]) == gen, bar);
            __builtin_amdgcn_fence(__ATOMIC_ACQUIRE, "agent");
            asm volatile("s_waitcnt vmcnt(0)" ::: "memory");
        }
    }
    __syncthreads();
}

namespace pg8 {
constexpr int BM = 256, BK = 64, HALF = 128, HTB = HALF * BK * 2, STAGE_BYTES = 8 * HTB, NXCD = 8, WGM = 8;
__device__ __forceinline__ int lds_byte(int r, int c) { const int st = (r >> 4) * 2 + (c >> 5), rr = r & 15, cc = c & 31, ob = rr * 64 + cc * 2; return st * 1024 + (ob ^ (((ob >> 9) & 1) << 5)); }
__device__ __forceinline__ void stage_rc(int b, int& R, int& C) { const int st = b / 1024, sb = b % 1024, swz = sb ^ (((sb >> 9) & 1) << 5); R = (st >> 1) * 16 + swz / 64; C = (st & 1) * 32 + (swz % 64) / 2; }

__device__ __forceinline__ int perm32(int rho) { const int n = rho >> 4, i = rho & 15; return 8 * (i >> 2) + 4 * n + (i & 3); }
struct Unit { int pm, pn, e, r0, slot; };
__device__ __forceinline__ void swz_tile(int wgid, int nM, int nN, int& pm, int& pn) {
    const int nwg = nM * nN;
    { const int q = nwg / NXCD, r = nwg % NXCD, xcd = wgid % NXCD, off = wgid / NXCD; wgid = (xcd < r ? xcd * (q + 1) : r * (q + 1) + (xcd - r) * q) + off; }
    const int nig = WGM * nN, gid = wgid / nig, fm = gid * WGM, gsz = (nM - fm) < WGM ? (nM - fm) : WGM;
    pm = fm + ((wgid % nig) % gsz); pn = (wgid % nig) / gsz;
}

typedef int v8i_t __attribute__((ext_vector_type(8)));
__device__ __forceinline__ int f8_byte(int r, int kq) { const int rr = r & 15; return ((r >> 4) * 2 + (kq >> 1)) * 1024 + ((rr * 64 + (kq & 1) * 32) ^ (((rr >> 3) & 1) << 5)); }
template <class Epi, class Sched, bool FP8>
__device__ __forceinline__ void gemm_phase(LAS unsigned char* lds, const char* Abase, const int KB, const Sched& S, const Epi& E) {
    int tid = threadIdx.x; asm volatile("" : "+v"(tid));
    const int wid = __builtin_amdgcn_readfirstlane(tid >> 6), lane = tid & 63, wr = wid >> 2, wc = wid & 3, fr = lane & 15, fq = lane >> 4;
    const int nt = KB / 128;
    unsigned voffB[2];
#pragma unroll
    for (int i = 0; i < 2; ++i) { int R_, C_; stage_rc(tid * 16 + i * 8192, R_, C_); const int Rb_ = Epi::PERM ? ((R_ & ~31) + perm32(R_ & 31)) : R_; voffB[i] = (unsigned)(Rb_ * KB + C_ * 2); }
#define PG8_ROWOFFS(U, o00, o01, o10, o11) do { int t_ = tid; asm volatile("" : "+v"(t_)); int R0_, C0_, R1_, C1_; stage_rc(t_ * 16, R0_, C0_); stage_rc(t_ * 16 + 8192, R1_, C1_); \
        o00 = S.a_rowoff(U, R0_) + C0_ * 2; o01 = S.a_rowoff(U, R1_) + C1_ * 2; o10 = S.a_rowoff(U, HALF + R0_) + C0_ * 2; o11 = S.a_rowoff(U, HALF + R1_) + C1_ * 2; } while (0)
    const size_t kstep = (size_t)(BK * 2);
    const size_t hstep = (size_t)HALF * KB;
    const unsigned ldsw = (unsigned)wid * 1024u;
    const int aoff = FP8 ? f8_byte(wr * 64 + fr, fq) : lds_byte(wr * 64 + fr, fq * 8), boff = FP8 ? f8_byte(wc * 32 + fr, fq) : lds_byte(wc * 32 + fr, fq * 8);
    constexpr int FSTEP = FP8 ? 16 : 1024;
#define PG8_SA(b, h) (((b) * 2 + (h)) * HTB)
#define PG8_SB(b, h) ((4 + (b) * 2 + (h)) * HTB)
#define PG8_STAGE_B(bufoff, gbase) do { _Pragma("unroll") for (int _i = 0; _i < 2; ++_i) \
        __builtin_amdgcn_global_load_lds((const unsigned*)((const char*)(gbase) + voffB[_i]), (LAS unsigned*)(lds + (bufoff) + ldsw + _i * 8192), 16, 0, 0); } while (0)
#define PG8_STAGE_A(bufoff, gbase, o0, o1) do { \
        __builtin_amdgcn_global_load_lds((const unsigned*)((const char*)(gbase) + (o0)), (LAS unsigned*)(lds + (bufoff) + ldsw), 16, 0, 0); \
        __builtin_amdgcn_global_load_lds((const unsigned*)((const char*)(gbase) + (o1)), (LAS unsigned*)(lds + (bufoff) + ldsw + 8192), 16, 0, 0); } while (0)
typedef int v4i_t __attribute__((ext_vector_type(4)));
#define PG8_LDA(dst, b, h) do { _Pragma("unroll") for (int m = 0; m < 4; ++m) { dst[m].lo = *(const LAS v4i_t*)(lds + PG8_SA(b, h) + aoff + m * 2048); dst[m].hi = *(const LAS v4i_t*)(lds + PG8_SA(b, h) + aoff + m * 2048 + FSTEP); } } while (0)
#define PG8_LDB(dst, b, h) do { _Pragma("unroll") for (int n = 0; n < 2; ++n) { dst[n].lo = *(const LAS v4i_t*)(lds + PG8_SB(b, h) + boff + n * 2048); dst[n].hi = *(const LAS v4i_t*)(lds + PG8_SB(b, h) + boff + n * 2048 + FSTEP); } } while (0)
#define PG8_MMA(ai, bj, At, Bt) do { __builtin_amdgcn_s_setprio(1); _Pragma("unroll") for (int m = 0; m < 4; ++m) _Pragma("unroll") for (int n = 0; n < 2; ++n) { \
        if constexpr (FP8) asm volatile("v_mfma_f32_16x16x128_f8f6f4 %0, %1, %2, %0" : "+v"(acc[ai][bj][m][n]) : "v"(Bt[n]), "v"(At[m]));   \
        else { const v4i_t bl_ = Bt[n].lo, bh_ = Bt[n].hi, al_ = At[m].lo, ah_ = At[m].hi;     \
               acc[ai][bj][m][n] = __builtin_amdgcn_mfma_f32_16x16x32_bf16(__builtin_bit_cast(bf16x8, bl_), __builtin_bit_cast(bf16x8, al_), acc[ai][bj][m][n], 0, 0, 0); \
               acc[ai][bj][m][n] = __builtin_amdgcn_mfma_f32_16x16x32_bf16(__builtin_bit_cast(bf16x8, bh_), __builtin_bit_cast(bf16x8, ah_), acc[ai][bj][m][n], 0, 0, 0); } } __builtin_amdgcn_s_setprio(0); } while (0)
#define PG8_WAIT_V(n) asm volatile("s_waitcnt vmcnt(" #n ")" ::: "memory")
#define PG8_WAIT_L(n) asm volatile("s_waitcnt lgkmcnt(" #n ")" ::: "memory")
#define PG8_BAR __builtin_amdgcn_s_barrier()
#define PG8_SCHED __builtin_amdgcn_sched_barrier(0)
    Unit cur, nxt; int ui = 0;
    if (!S.next(0, cur)) return;
    f32x4 acc[2][2][4][2];
#pragma unroll
    for (int a = 0; a < 2; ++a)
#pragma unroll
        for (int b = 0; b < 2; ++b)
#pragma unroll
            for (int m = 0; m < 4; ++m)
#pragma unroll
                for (int n = 0; n < 2; ++n) acc[a][b][m][n] = (f32x4){0.f, 0.f, 0.f, 0.f};
    v8i_t At[4], B0[2], B1[2];
    unsigned c00, c01, c10, c11, n00, n01, n10, n11;
    PG8_ROWOFFS(cur, c00, c01, c10, c11);
    const char* cB = S.b_ptr(cur);
    const char* cA = Abase;
    PG8_STAGE_B(PG8_SB(0, 0), cB); PG8_STAGE_B(PG8_SB(0, 1), cB + hstep); PG8_STAGE_A(PG8_SA(0, 0), cA, c00, c01); PG8_STAGE_A(PG8_SA(0, 1), cA, c10, c11);
    if (wr == 1) PG8_BAR;
    PG8_WAIT_V(2); PG8_BAR;
    PG8_STAGE_B(PG8_SB(1, 0), cB + kstep); PG8_STAGE_A(PG8_SA(1, 0), cA + kstep, c00, c01); PG8_STAGE_B(PG8_SB(1, 1), cB + hstep + kstep);
    PG8_WAIT_V(6); PG8_BAR;
    for (;;) {
        const bool has_next = S.next(ui + 1, nxt);
        const char* nB = has_next ? S.b_ptr(nxt) : cB;
        if (has_next) { PG8_ROWOFFS(nxt, n00, n01, n10, n11); }
        else { n00 = c00; n01 = c01; n10 = c10; n11 = c11; }
#pragma nounroll
        for (int t = 0; t < nt; t += 2) {
            const bool last = (t == nt - 2);
            const char* a1 = cA + (size_t)(t + 1) * kstep;
            const char* a2 = last ? cA : cA + (size_t)(t + 2) * kstep; const char* b2 = last ? nB : cB + (size_t)(t + 2) * kstep;
            const char* a3 = a2 + kstep; const char* b3 = b2 + kstep;
            const unsigned x00 = last ? n00 : c00, x01 = last ? n01 : c01, x10 = last ? n10 : c10, x11 = last ? n11 : c11;
            PG8_LDB(B0, 0, 0); PG8_LDB(B1, 0, 1); PG8_SCHED; PG8_LDA(At, 0, 0); PG8_STAGE_A(PG8_SA(1, 1), a1, c10, c11);
            PG8_WAIT_V(8); PG8_WAIT_L(0); PG8_BAR; PG8_MMA(0, 0, At, B0); PG8_MMA(0, 1, At, B1); PG8_BAR; PG8_SCHED;
            PG8_LDA(At, 0, 1); PG8_STAGE_B(PG8_SB(0, 0), b2); PG8_STAGE_B(PG8_SB(0, 1), b2 + hstep); PG8_STAGE_A(PG8_SA(0, 0), a2, x00, x01);
            PG8_WAIT_V(8); PG8_WAIT_L(0); PG8_BAR; PG8_MMA(1, 0, At, B0); PG8_MMA(1, 1, At, B1); PG8_BAR; PG8_SCHED;
            PG8_LDB(B0, 1, 0); PG8_LDB(B1, 1, 1); PG8_SCHED; PG8_LDA(At, 1, 0); PG8_STAGE_A(PG8_SA(0, 1), a2, x10, x11);
            PG8_WAIT_V(8); PG8_WAIT_L(0); PG8_BAR; PG8_MMA(0, 0, At, B0); PG8_MMA(0, 1, At, B1); PG8_BAR; PG8_SCHED;
            PG8_LDA(At, 1, 1); PG8_STAGE_B(PG8_SB(1, 0), b3); PG8_STAGE_B(PG8_SB(1, 1), b3 + hstep); PG8_STAGE_A(PG8_SA(1, 0), a3, x00, x01);
            PG8_WAIT_V(8); PG8_WAIT_L(0); PG8_BAR; PG8_MMA(1, 0, At, B0); PG8_MMA(1, 1, At, B1); PG8_BAR; PG8_SCHED;
        }
        if constexpr (FP8) {
#pragma unroll
            for (int a_ = 0; a_ < 2; ++a_)
#pragma unroll
                for (int b_ = 0; b_ < 2; ++b_)
                    asm volatile("s_nop 15" : "+v"(acc[a_][b_][0][0]), "+v"(acc[a_][b_][0][1]), "+v"(acc[a_][b_][1][0]), "+v"(acc[a_][b_][1][1]), "+v"(acc[a_][b_][2][0]), "+v"(acc[a_][b_][2][1]), "+v"(acc[a_][b_][3][0]), "+v"(acc[a_][b_][3][1]));
        }
        if (wr == 0) PG8_BAR;
        { int fr_ = fr, fq_ = fq; asm volatile("" : "+v"(fr_), "+v"(fq_));
          E(acc, cur, wr, wc, fr_, fq_); }
        if (!has_next) break;
#pragma unroll
        for (int a = 0; a < 2; ++a)
#pragma unroll
            for (int b = 0; b < 2; ++b)
#pragma unroll
                for (int m = 0; m < 4; ++m)
#pragma unroll
                    for (int n = 0; n < 2; ++n) acc[a][b][m][n] = (f32x4){0.f, 0.f, 0.f, 0.f};
        cur = nxt; cB = nB; c00 = n00; c01 = n01; c10 = n10; c11 = n11; ++ui;
        if (wr == 1) PG8_BAR;
    }
    PG8_WAIT_V(0);
    PG8_BAR;
#undef PG8_ROWOFFS
#undef PG8_SA
#undef PG8_SB
#undef PG8_STAGE_A
#undef PG8_STAGE_B
#undef PG8_LDA
#undef PG8_LDB
#undef PG8_MMA
#undef PG8_WAIT_V
#undef PG8_WAIT_L
#undef PG8_BAR
#undef PG8_SCHED
}
}
using pg8::Unit;

struct SchedPlain {
    int nM, nN, nX, xpm0, xpn, G, c; unsigned rowbytes; const char* Bt; size_t btile;
    __device__ __forceinline__ bool next(int i, Unit& u) const {
        const int L = i * G + c, nwg = nM * nN;
        if (L < nwg) { pg8::swz_tile(L, nM, nN, u.pm, u.pn); }
        else if (L < nwg + nX) { u.pm = xpm0 + (L - nwg); u.pn = xpn; }
        else return false;
        u.e = 0; u.r0 = u.pm * 256; u.slot = i; return true;
    }
    __device__ __forceinline__ unsigned a_rowoff(const Unit& u, int r) const { return (unsigned)(u.r0 + r) * rowbytes; }
    __device__ __forceinline__ const char* b_ptr(const Unit& u) const { return Bt + (size_t)u.pn * btile; }
};
struct SchedOne {
    int pm, pn; unsigned rowbytes; const char* Bt; size_t btile;
    __device__ __forceinline__ bool next(int i, Unit& u) const { if (i != 0) return false; u.pm = pm; u.pn = pn; u.e = 0; u.r0 = pm * 256; u.slot = 0; return true; }
    __device__ __forceinline__ unsigned a_rowoff(const Unit& u, int r) const { return (unsigned)(u.r0 + r) * rowbytes; }
    __device__ __forceinline__ const char* b_ptr(const Unit& u) const { return Bt + (size_t)u.pn * btile; }
};
template <bool GATHER> struct SchedMoe {
    int ntile, G, c; unsigned rowbytes; const char* Bt; size_t btile, bexp;
    LAS const int* tile_e; LAS const int* tile_r0; LAS const int* idx;
    __device__ __forceinline__ bool next(int i, Unit& u) const {
        const int L = i * G + c; if (L >= 4 * ntile) return false;
        const int t = L >> 2; u.pn = L & 3; u.pm = t; u.e = __builtin_amdgcn_readfirstlane(tile_e[t]); u.r0 = __builtin_amdgcn_readfirstlane(tile_r0[t]); u.slot = i; return true;
    }
    __device__ __forceinline__ unsigned a_rowoff(const Unit& u, int r) const {
        if (GATHER) return (unsigned)idx[u.slot * 256 + r];
        else return (unsigned)(u.r0 + r) * rowbytes;
    }
    __device__ __forceinline__ const char* b_ptr(const Unit& u) const { return Bt + (size_t)u.e * bexp + (size_t)u.pn * btile; }
};

struct EpiProj {
    static constexpr bool PERM = true;
    bf16_t* O; LAS const float* rope;
    __device__ __forceinline__ void operator()(const f32x4 (&acc)[2][2][4][2], const Unit& u, int wr, int wc, int fr, int fq) const {
        const int row0 = u.pm * 256 + wr * 64 + fr, col0 = u.pn * 256 + wc * 32 + 8 * fq;
        const bool lat = (u.pm * 256) < NLAT;
        const float qs = (u.pn < 2) ? QSCALE : 1.0f;
        const bool anyrot = lat && u.pn <= 2;
        const float sgn = (fq < 2) ? -1.0f : 1.0f;
#pragma unroll
        for (int ai = 0; ai < 2; ++ai)
#pragma unroll
            for (int m = 0; m < 4; ++m) {
                const int row = row0 + ai * 128 + m * 16;
                bf16_t* rowp = O + (size_t)row * INW + col0;
                const int t = row & (SEQ - 1);
                const int pos = (wc & 1) ? (t & 63) : (t >> 6);
                f32x4 cs[2], sn[2];
                if (anyrot) {
#pragma unroll
                    for (int n = 0; n < 2; ++n) { cs[n] = *(LAS const f32x4*)(rope + pos * 16 + 8 * (fq & 1) + 4 * n); sn[n] = *(LAS const f32x4*)(rope + 1024 + pos * 16 + 8 * (fq & 1) + 4 * n) * sgn; }
                }
#pragma unroll
                for (int bj = 0; bj < 2; ++bj) {
                    f32x4 v[2] = {acc[ai][bj][m][0], acc[ai][bj][m][1]};
                    if (anyrot) {
                        const bool rot = (u.pn < 2) || (bj == 0);
#pragma unroll
                        for (int n = 0; n < 2; ++n) {
                            f32x4 p;
#pragma unroll
                            for (int j = 0; j < 4; ++j) { const unsigned xb_ = __float_as_uint(v[n][j]); const auto rr_ = __builtin_amdgcn_permlane32_swap(xb_, xb_, false, false);
                                p[j] = __uint_as_float((fq < 2) ? rr_[1] : rr_[0]); }
                            if (rot) v[n] = v[n] * cs[n] + p * sn[n];
                        }
                    }
                    u32x4 w; w.x = pk2(v[0][0] * qs, v[0][1] * qs); w.y = pk2(v[0][2] * qs, v[0][3] * qs); w.z = pk2(v[1][0] * qs, v[1][1] * qs); w.w = pk2(v[1][2] * qs, v[1][3] * qs);
                    *(u32x4*)(rowp + bj * 128) = w;
                }
            }
    }
};
struct EpiOut {
    static constexpr bool PERM = true;
    bf16_t* xb; const float* mod_l; float* pstat;
    __device__ __forceinline__ void operator()(const f32x4 (&acc)[2][2][4][2], const Unit& u, int wr, int wc, int fr, int fq) const {
        const int row0 = u.pm * 256 + wr * 64 + fr, col0 = u.pn * 256 + wc * 32 + 8 * fq;
        const int tr0 = u.pm * 256;
        const int mr = (tr0 < NLAT) ? (tr0 / SEQ) : 8;
        const float* gate = mod_l + mr * 6144 + 2 * D;
        f32x4 gv[2][2];
#pragma unroll
        for (int bj = 0; bj < 2; ++bj)
#pragma unroll
            for (int n = 0; n < 2; ++n) gv[bj][n] = *(const f32x4*)(gate + col0 + bj * 128 + n * 4);
#pragma unroll
        for (int ai = 0; ai < 2; ++ai) {
            u32x4 xi[4][2];
#pragma unroll
            for (int m = 0; m < 4; ++m) { const bf16_t* sp = xb + (size_t)(row0 + ai * 128 + m * 16) * D + col0;
#pragma unroll
                for (int bj = 0; bj < 2; ++bj) xi[m][bj] = *(const u32x4*)(sp + bj * 128); }
#pragma unroll
            for (int m = 0; m < 4; ++m) {
                const int row = row0 + ai * 128 + m * 16;
                bf16_t* dp = xb + (size_t)row * D + col0;
#pragma unroll
                for (int bj = 0; bj < 2; ++bj) {
                    const u32x4 xw = xi[m][bj];
                    const f32x4 y0 = ALPHA * (f32x4){bflo(xw.x), bfhi(xw.x), bflo(xw.y), bfhi(xw.y)} + gv[bj][0] * acc[ai][bj][m][0];
                    const f32x4 y1 = ALPHA * (f32x4){bflo(xw.z), bfhi(xw.z), bflo(xw.w), bfhi(xw.w)} + gv[bj][1] * acc[ai][bj][m][1];
                    u32x4 w; w.x = pk2(y0[0], y0[1]); w.y = pk2(y0[2], y0[3]); w.z = pk2(y1[0], y1[1]); w.w = pk2(y1[2], y1[3]);
                    *(u32x4*)(dp + bj * 128) = w;
                    float s = ((y0[0] + y0[1]) + (y0[2] + y0[3])) + ((y1[0] + y1[1]) + (y1[2] + y1[3]));
                    float q = ((y0[0] * y0[0] + y0[1] * y0[1]) + (y0[2] * y0[2] + y0[3] * y0[3])) + ((y1[0] * y1[0] + y1[1] * y1[1]) + (y1[2] * y1[2] + y1[3] * y1[3]));
                    s += __shfl_xor(s, 16); s += __shfl_xor(s, 32); q += __shfl_xor(q, 16); q += __shfl_xor(q, 32);
                    if (fq == 0) *(f32x2*)(pstat + ((size_t)row * 32 + u.pn * 8 + bj * 4 + wc) * 2) = (f32x2){s, q};
                }
            }
        }
    }
};
struct EpiH {
    static constexpr bool PERM = true;
    unsigned char* H;
    __device__ __forceinline__ void operator()(const f32x4 (&acc)[2][2][4][2], const Unit& u, int wr, int wc, int fr, int fq) const {
        const int row0 = u.r0 + wr * 64 + fr, col0 = u.pn * 128 + wc * 32 + 8 * fq;
        constexpr float IS = 1.0f / W8_SCALE, OS = H8_SCALE / W8_SCALE;
#pragma unroll
        for (int ai = 0; ai < 2; ++ai)
#pragma unroll
            for (int m = 0; m < 4; ++m) {
                unsigned char* rowp = H + (size_t)(row0 + ai * 128 + m * 16) * DE + col0;
                u32x2 w;
                { const f32x4 a = acc[ai][0][m][0] * IS, b = acc[ai][1][m][0] * OS; w.x = pk4_fp8(silu_f(a[0]) * b[0], silu_f(a[1]) * b[1], silu_f(a[2]) * b[2], silu_f(a[3]) * b[3]); }
                { const f32x4 a = acc[ai][0][m][1] * IS, b = acc[ai][1][m][1] * OS; w.y = pk4_fp8(silu_f(a[0]) * b[0], silu_f(a[1]) * b[1], silu_f(a[2]) * b[2], silu_f(a[3]) * b[3]); }
                *(u32x2*)rowp = w;
            }
    }
};
struct EpiY {
    static constexpr bool PERM = true;
    unsigned char* Y;
    __device__ __forceinline__ void operator()(const f32x4 (&acc)[2][2][4][2], const Unit& u, int wr, int wc, int fr, int fq) const {
        const int row0 = u.r0 + wr * 64 + fr, col0 = u.pn * 256 + wc * 32 + 8 * fq;
        constexpr float OS = Y8_SCALE / (H8_SCALE * W8_SCALE);
#pragma unroll
        for (int ai = 0; ai < 2; ++ai)
#pragma unroll
            for (int m = 0; m < 4; ++m) {
                unsigned char* rowp = Y + (size_t)(row0 + ai * 128 + m * 16) * D + col0;
#pragma unroll
                for (int bj = 0; bj < 2; ++bj) { const f32x4 a = acc[ai][bj][m][0] * OS, b = acc[ai][bj][m][1] * OS;
                    u32x2 w; w.x = pk4_fp8(a[0], a[1], a[2], a[3]); w.y = pk4_fp8(b[0], b[1], b[2], b[3]); *(u32x2*)(rowp + bj * 128) = w; }
            }
    }
};

struct Args { const float* in[23]; float* out; unsigned char* ws; int ph_lo, ph_hi; };
typedef __attribute__((address_space(4))) const Args CArgs;
enum { I_X = 0, I_C, I_CTX, I_CCTX, I_WADA, I_BADA, I_WIN, I_CONVW, I_SINK, I_GMWS, I_GMBS, I_WOUT, I_LN1G, I_LN1B, I_WRG, I_BRG, I_WRE, I_BRE, I_W1, I_W3, I_W2, I_LN2G, I_LN2B };
constexpr int NPH = 16;

__device__ __forceinline__ void transpose_item(const float* W, int ldw, int k0, int n0, bf16_t* dst, int ldt, LAS float* scr, int lane) {
    float tv[32];
#pragma unroll
    for (int i = 0; i < 32; ++i) tv[i] = W[(size_t)(k0 + 2 * i + (lane >> 5)) * ldw + n0 + (lane & 31)];
#pragma unroll
    for (int i = 0; i < 32; ++i) scr[(2 * i + (lane >> 5)) * 33 + (lane & 31)] = tv[i];
    LDS_WAIT(); asm volatile("" ::: "memory");
    const int c = lane & 7;
#pragma unroll
    for (int j = 0; j < 4; ++j) { const int n = (lane >> 3) + 8 * j; const LAS float* s = scr + (8 * c) * 33 + n;
        u32x4 o; o.x = pk2(s[0 * 33], s[1 * 33]); o.y = pk2(s[2 * 33], s[3 * 33]); o.z = pk2(s[4 * 33], s[5 * 33]); o.w = pk2(s[6 * 33], s[7 * 33]);
        *(u32x4*)(dst + (size_t)n * ldt + k0 + 8 * c) = o; }
    LDS_WAIT(); asm volatile("" ::: "memory");
}
__device__ __forceinline__ void transpose_item8(const float* W, int ldw, int k0, int n0, unsigned char* dst8, int ldt, float scale, LAS float* scr, int lane) {
    float tv[32];
#pragma unroll
    for (int i = 0; i < 32; ++i) tv[i] = W[(size_t)(k0 + 2 * i + (lane >> 5)) * ldw + n0 + (lane & 31)];
#pragma unroll
    for (int i = 0; i < 32; ++i) scr[(2 * i + (lane >> 5)) * 33 + (lane & 31)] = tv[i];
    LDS_WAIT(); asm volatile("" ::: "memory");
    const int c = lane & 7;
#pragma unroll
    for (int j = 0; j < 4; ++j) { const int n = (lane >> 3) + 8 * j; const LAS float* sp = scr + (8 * c) * 33 + n;
        u32x2 o; o.x = pk4_fp8(sp[0 * 33] * scale, sp[1 * 33] * scale, sp[2 * 33] * scale, sp[3 * 33] * scale); o.y = pk4_fp8(sp[4 * 33] * scale, sp[5 * 33] * scale, sp[6 * 33] * scale, sp[7 * 33] * scale);
        *(u32x2*)(dst8 + (size_t)n * ldt + k0 + 8 * c) = o; }
    LDS_WAIT(); asm volatile("" ::: "memory");
}
constexpr int CV_I13 = NE * 16 * 16, CV_I2 = NE * 8 * 32, CV_ITEMS = 2 * CV_I13 + CV_I2, CV_UNITS = CV_ITEMS / 64;
__device__ __forceinline__ void convert_item(const float* w1, const float* w3, const float* w2, bf16_t* W13T, bf16_t* W2T, int l, int it, LAS float* scr, int lane) {
    if (it < 2 * CV_I13) {
        const int which = it / CV_I13, r = it % CV_I13, e = r / 256, q = r % 256, kb = q / 16, nb = q % 16, n0 = nb * 32;
        const float* W = (which ? w3 : w1) + ((size_t)l * NE + e) * (size_t)D * DE;
        unsigned char* dst = (unsigned char*)W13T + ((size_t)e * 1024 + (n0 >> 7) * 256 + which * 128 + (n0 & 127)) * D;
        transpose_item8(W, DE, kb * 64, n0, dst, D, W8_SCALE, scr, lane);
    } else {
        const int r = it - 2 * CV_I13, e = r / 256, q = r % 256, kb = q / 32, nb = q % 32, n0 = nb * 32;
        const float* W = w2 + ((size_t)l * NE + e) * (size_t)DE * D;
        unsigned char* dst = (unsigned char*)W2T + ((size_t)e * 1024 + n0) * DE;
        transpose_item8(W, D, kb * 64, n0, dst, DE, W8_SCALE, scr, lane);
    }
}

struct CvItem { const float* W; unsigned char* dst; int ldw, ldt, k0, n0; };
__device__ __forceinline__ CvItem cv_decode(const float* w1, const float* w3, const float* w2, bf16_t* W13T, bf16_t* W2T, int l, int it) {
    CvItem c;
    if (it < 2 * CV_I13) {
        const int which = it / CV_I13, r = it % CV_I13, e = r / 256, q = r % 256, kb = q / 16, nb = q % 16, n0 = nb * 32;
        c.W = (which ? w3 : w1) + ((size_t)l * NE + e) * (size_t)D * DE; c.ldw = DE; c.k0 = kb * 64; c.n0 = n0;
        c.dst = (unsigned char*)W13T + ((size_t)e * 1024 + (n0 >> 7) * 256 + which * 128 + (n0 & 127)) * D; c.ldt = D;
    } else {
        const int r = it - 2 * CV_I13, e = r / 256, q = r % 256, kb = q / 32, nb = q % 32, n0 = nb * 32;
        c.W = w2 + ((size_t)l * NE + e) * (size_t)DE * D; c.ldw = D; c.k0 = kb * 64; c.n0 = n0;
        c.dst = (unsigned char*)W2T + ((size_t)e * 1024 + n0) * DE; c.ldt = DE;
    }
    return c;
}
__device__ __forceinline__ void cv_load(const CvItem& c, int lane, f32x4 (&t)[8]) {
#pragma unroll
    for (int i = 0; i < 8; ++i) t[i] = __builtin_nontemporal_load((const f32x4*)(c.W + (size_t)(c.k0 + 8 * i + (lane >> 3)) * c.ldw + c.n0 + 4 * (lane & 7)));
}
__device__ __forceinline__ void cv_store(const CvItem& c, const f32x4 (&t)[8], LAS float* scr, int lane) {
#pragma unroll
    for (int i = 0; i < 8; ++i) { LAS float* p = scr + (8 * i + (lane >> 3)) * 33 + 4 * (lane & 7); p[0] = t[i][0]; p[1] = t[i][1]; p[2] = t[i][2]; p[3] = t[i][3]; }
    LDS_WAIT(); asm volatile("" ::: "memory");
    const int kc = lane & 7;
#pragma unroll
    for (int j = 0; j < 4; ++j) { const int n = (lane >> 3) + 8 * j; const LAS float* sp = scr + (8 * kc) * 33 + n;
        u32x2 o; o.x = pk4_fp8(sp[0 * 33] * W8_SCALE, sp[1 * 33] * W8_SCALE, sp[2 * 33] * W8_SCALE, sp[3 * 33] * W8_SCALE); o.y = pk4_fp8(sp[4 * 33] * W8_SCALE, sp[5 * 33] * W8_SCALE, sp[6 * 33] * W8_SCALE, sp[7 * 33] * W8_SCALE);
        *(u32x2*)(c.dst + (size_t)n * c.ldt + c.k0 + 8 * kc) = o; }
    LDS_WAIT(); asm volatile("" ::: "memory");
}
__device__ __forceinline__ void convert_unit(const float* w1, const float* w3, const float* w2, bf16_t* W13T, bf16_t* W2T, int l, int cvu, int wave, LAS float* scr, int lane) {
    const int it0 = cvu * 64 + wave * 8;
    CvItem cur = cv_decode(w1, w3, w2, W13T, W2T, l, it0);
    f32x4 ta[8], tb[8];
    cv_load(cur, lane, ta);
#pragma unroll 1
    for (int j = 0; j < 8; j += 2) {
        const CvItem n1 = cv_decode(w1, w3, w2, W13T, W2T, l, it0 + j + 1);
        cv_load(n1, lane, tb);
        cv_store(cur, ta, scr, lane);
        CvItem n2 = n1;
        if (j + 2 < 8) { n2 = cv_decode(w1, w3, w2, W13T, W2T, l, it0 + j + 2); cv_load(n2, lane, ta); }
        cv_store(n1, tb, scr, lane);
        cur = n2;
    }
}

__global__ void __launch_bounds__(512, 2) fwd_kernel(Args args) {
    extern __shared__ __attribute__((aligned(16))) unsigned char lds_raw[];
    LAS unsigned char* lds = (LAS unsigned char*)lds_raw;
    volatile LAS unsigned* MISC = (volatile LAS unsigned*)(lds + MISC_OFF);
    const int tid = threadIdx.x, lane = tid & 63, wave = __builtin_amdgcn_readfirstlane(tid >> 6);
    const int G = gridDim.x, bx = blockIdx.x;
    const int gw = bx * 8 + wave, NGW = G * 8;
#define KARGS() ({ CArgs* _kp = (CArgs*)__builtin_amdgcn_kernarg_segment_ptr(); asm volatile("" : "+s"(_kp)); _kp; })
#define PHASE_PTRS() CArgs* kp = KARGS(); unsigned char* const ws = kp->ws; int tid = threadIdx.x; asm volatile("" : "+v"(tid)); const int lane = tid & 63
#define ctl ((gu32*)(ws + WS_CTL))
#define modall ((float*)(ws + WS_MOD))
#define rope ((float*)(ws + WS_ROPE))
#define gmw ((bf16_t*)(ws + WS_GMW))
#define tokinfo ((int*)(ws + WS_TOKINFO))
#define gates ((float*)(ws + WS_GATES))
#define elist ((int*)(ws + WS_LIST))
#define WinT ((bf16_t*)(ws + WS_WIN))
#define WoutT ((bf16_t*)(ws + WS_WOUT))
#define W13T ((bf16_t*)(ws + WS_W13))
#define W2T ((bf16_t*)(ws + WS_W2))
#define hx ((bf16_t*)(ws + WS_HX))
#define xbuf ((bf16_t*)(ws + WS_XBUF))
#define proj ((bf16_t*)(ws + WS_PROJ))
#define mix ((bf16_t*)(ws + WS_MIX))
#define Hb ((bf16_t*)(ws + WS_H))
#define Yb ((bf16_t*)(ws + WS_Y))
#define mod_l (modall + (size_t)l * 9 * 6144)
#define cnt_l (ctl + CW_CNT + l * 64)
    CArgs* kp0 = KARGS();
    for (int u = tid; u < 64; u += 512) ((LAS unsigned*)(lds + MISC_OFF))[u] = 0u;
    __syncthreads();
    XcdBarrier bar; bar.bar = (unsigned*)(kp0->ws + WS_CTL) + CW_BAR; bar.x = 0; bar.st = nullptr;
    if (MK_N_LAUNCHES == 1) bar = xcd_barrier_post((unsigned*)(kp0->ws + WS_CTL) + CW_BAR, MISC + 8);
    const int lo = kp0->ph_lo, hi = kp0->ph_hi;
#ifndef PH_MASK
#define PH_MASK 0xFFFFFFFFu
#endif
#define IN(k) (((PH_MASK >> ((k) < 2 ? (k) : 2 + ((k) - 2) % 7)) & 1u) && lo <= (k) && (k) < hi)
#if defined(PROBE_A)
    unsigned long long pr_prev = __builtin_amdgcn_s_memrealtime(), pr_a = 0, pr_b = 0;
#define PROBE_MARK(k) do { const unsigned long long now_ = __builtin_amdgcn_s_memrealtime(); if ((PROBE_A >> (k)) & 1u) pr_a += now_ - pr_prev; if ((PROBE_B >> (k)) & 1u) pr_b += now_ - pr_prev; pr_prev = now_; } while (0)
#else
#define PROBE_MARK(k) do { } while (0)
#endif
#define GRID_BAR(k) do { if (IN(k) && IN((k) + 1)) xcd_barrier(bar); PROBE_MARK(k); } while (0)

    if (IN(0)) {
            PHASE_PTRS();
        LAS float* cs = (LAS float*)(lds + 73728);
        LAS float* red = (LAS float*)(lds + 73728 + 36864);
        {
            f32x4 t_[5];
#pragma unroll
            for (int i = 0; i < 5; ++i) { const int idx = tid + 512 * i; if (idx < 9 * D / 4) { const int r = idx >> 8, k4 = (idx & 255) * 4; t_[i] = (r < 8) ? *(const f32x4*)(kp->in[I_C] + r * D + k4) : *(const f32x4*)(kp->in[I_CCTX] + k4); } }
#pragma unroll
            for (int i = 0; i < 5; ++i) { const int idx = tid + 512 * i; if (idx < 9 * D / 4) { *(LAS f32x4*)(cs + 4 * idx) = (f32x4){silu_f(t_[i][0]), silu_f(t_[i][1]), silu_f(t_[i][2]), silu_f(t_[i][3])}; } }
        }
        __syncthreads();
        for (int item = bx; item < 2 * 96; item += G) {
            const int l = item / 96, n0 = (item % 96) * 64;
            const int kq = lane >> 4, cg = lane & 15;
            const float* wp = kp->in[I_WADA] + ((size_t)l * D + wave * 128 + kq) * 6144 + n0 + 4 * cg;
            f32x4 a[9];
#pragma unroll
            for (int r = 0; r < 9; ++r) a[r] = (f32x4){0.f, 0.f, 0.f, 0.f};
#pragma unroll 4
            for (int i = 0; i < 32; ++i) {
                const f32x4 w = __builtin_nontemporal_load((const f32x4*)(wp + (size_t)(4 * i) * 6144));
                const int k = wave * 128 + 4 * i + kq;
#pragma unroll
                for (int r = 0; r < 9; ++r) a[r] += cs[r * D + k] * w;
            }
#pragma unroll
            for (int r = 0; r < 9; ++r)
#pragma unroll
                for (int j = 0; j < 4; ++j) { float v = a[r][j]; v += __shfl_xor(v, 16); v += __shfl_xor(v, 32); a[r][j] = v; }
            if (kq == 0) {
#pragma unroll
                for (int r = 0; r < 9; ++r)
#pragma unroll
                    for (int j = 0; j < 4; ++j) red[(wave * 9 + r) * 64 + 4 * cg + j] = a[r][j];
            }
            __syncthreads();
            for (int i = tid; i < 9 * 64; i += 512) {
                const int r = i >> 6, cidx = i & 63; float s = 0.f;
#pragma unroll
                for (int w = 0; w < 8; ++w) s += red[(w * 9 + r) * 64 + cidx];
                modall[((size_t)l * 9 + r) * 6144 + n0 + cidx] = s + kp->in[I_BADA][l * 6144 + n0 + cidx];
            }
            __syncthreads();
        }
        if (bx == G - 1) {
            for (int i = tid; i < 1024; i += 512) { const int pos = i >> 4, f = i & 15; const float fr_ = powf(10000.0f, -(float)f / 16.0f); const float ang = (float)pos * fr_; rope[i] = cosf(ang); rope[1024 + i] = sinf(ang); }
        }
        for (int i = bx * 512 + tid; i < 2 * D * 36; i += G * 512) {
            const int l = i / (D * 36), r = i % (D * 36), k = r / 36, o_ = r % 36;
            const float w = (o_ < 4) ? kp->in[I_WRG][((size_t)l * D + k) * 4 + o_] : kp->in[I_WRE][((size_t)l * D + k) * 32 + (o_ - 4)];
            const unsigned hi_ = f2bf(w); const unsigned lo_ = f2bf(w - bf2f((unsigned short)hi_));
            bf16_t* img = (bf16_t*)(ws + WS_WRIMG + (size_t)l * WRIMG_BYTES);
            img[(o_ * WR_RS) / 2 + k] = (bf16_t)hi_; img[(WR_LO + o_ * WR_RS) / 2 + k] = (bf16_t)lo_;
        }
        for (int i = bx * 512 + tid; i < 2 * 4 * 128 * 128; i += G * 512) gmw[i] = (bf16_t)f2bf(kp->in[I_GMWS][i]);
        LAS float* scr = (LAS float*)(lds + wave * 9216);
        {
            constexpr int IW = 16 * 64, IO = 16 * 32;
            for (int it = gw; it < 2 * IW + 2 * IO; it += NGW) {
                if (it < 2 * IW) { const int l = it / IW, q = it % IW, kb = q / 64, nb = q % 64;
                    transpose_item(kp->in[I_WIN] + (size_t)l * D * INW, INW, kb * 64, nb * 32, WinT + ((size_t)l * INW + nb * 32) * D, D, scr, lane); }
                else { const int r = it - 2 * IW, l = r / IO, q = r % IO, kb = q / 32, nb = q % 32;
                    transpose_item(kp->in[I_WOUT] + (size_t)l * D * D, D, kb * 64, nb * 32, WoutT + ((size_t)l * D + nb * 32) * D, D, scr, lane); }
            }
        }
    }
    GRID_BAR(0);

    if (IN(1)) {
            PHASE_PTRS();
        for (int i = bx * 512 + tid; i < 2 * 9 * D; i += G * 512) {
            const int l = i / (9 * D), r = (i / D) % 9, c = i % D;
            const float* md = modall + ((size_t)l * 9 + r) * 6144;
            const float g = kp->in[I_LN1G][l * D + c], b = kp->in[I_LN1B][l * D + c], sc = md[4 * D + c], sh = md[3 * D + c];
            float* gc = (float*)(ws + WS_GC) + ((size_t)(l * 9 + r) * 2) * D;
            gc[c] = g * (1.0f + sc); gc[D + c] = b * (1.0f + sc) + sh;
        }
        for (int r = gw; r < NROW; r += NGW) {
            const float* src = (r < NLAT) ? kp->in[I_X] + (size_t)r * D : kp->in[I_CTX] + (size_t)(r - NLAT) * D;
            const float* md = modall + (size_t)((r < NLAT) ? (r / SEQ) : 8) * 6144;
            u32x2* dst = (u32x2*)(hx + (size_t)r * D);
#pragma unroll
            for (int j = 0; j < 4; ++j) {
                const int c = 256 * j + 4 * lane;
                const f32x4 v = __builtin_nontemporal_load((const f32x4*)(src + c)), sh = *(const f32x4*)(md + c), sc = *(const f32x4*)(md + D + c);
                const f32x4 h = v * (1.0f + sc) + sh;
                u32x2 w; w.x = pk2(h[0], h[1]); w.y = pk2(h[2], h[3]); dst[64 * j + lane] = w;
                u32x2 wx; wx.x = pk2(v[0], v[1]); wx.y = pk2(v[2], v[3]); ((u32x2*)(xbuf + (size_t)r * D))[64 * j + lane] = wx;
            }
        }
    }
    GRID_BAR(1);

    for (int l = 0; l < DEPTH; ++l) {
        const int pb = 2 + 7 * l;
        const bool lastl = (l == DEPTH - 1);
        const int nrow_l = lastl ? NLAT : NROW;

        if (IN(pb + 0)) {
            PHASE_PTRS();
            SchedPlain S; S.nM = NLAT / 256; S.nN = 8; S.nX = 0; S.xpm0 = 0; S.xpn = 0; S.G = G; S.c = bx;
            S.rowbytes = D * 2; S.Bt = (const char*)(WinT + (size_t)l * INW * D); S.btile = (size_t)256 * D * 2;
            __builtin_amdgcn_global_load_lds((const unsigned*)(rope + 256 * wave + 4 * lane), (LAS unsigned*)(lds + L_ROPE + 1024 * wave), 16, 0, 0);
            asm volatile("s_waitcnt vmcnt(0)" ::: "memory");
            __syncthreads();
            EpiProj E{proj, (LAS const float*)(lds + L_ROPE)};
            pg8::gemm_phase<EpiProj, SchedPlain, false>(lds, (const char*)hx, D * 2, S, E);
        }
        GRID_BAR(pb + 0);

        if (IN(pb + 1)) {
            PHASE_PTRS();
            const int n_att = NB * 32 * 2 + (lastl ? 0 : NB * 2 * 2);
            const int n_loc = nrow_l / 128;
            gu32* cproj = ctl + CW_DEP + l * 16; gu32* cmix = ctl + CW_DEP + 32;
            const unsigned need_proj = lastl ? 1u : 8u;
#define DEP_PUBLISH(ctr_) do { asm volatile("s_waitcnt vmcnt(0)" ::: "memory"); __syncthreads(); \
                if (threadIdx.x == 0) { __builtin_amdgcn_fence(__ATOMIC_RELEASE, "agent"); asm volatile("s_waitcnt vmcnt(0)" ::: "memory"); __hip_atomic_fetch_add((ctr_), 1u, __ATOMIC_RELAXED, __HIP_MEMORY_SCOPE_AGENT); } } while (0)
#define DEP_ENSURE(bit_, ctr_, need_) do { const unsigned m_ = MISC[24]; if (!((m_ >> (bit_)) & 1u)) { \
                if (threadIdx.x == 0) { unsigned sp_ = 0; while (__hip_atomic_load((ctr_), __ATOMIC_RELAXED, __HIP_MEMORY_SCOPE_AGENT) < (need_)) { __builtin_amdgcn_s_sleep(4); \
                        if (++sp_ > (1u << 22)) { __hip_atomic_store(ctl + CW_TMO, 1u, __ATOMIC_RELAXED, __HIP_MEMORY_SCOPE_AGENT); break; } } \
                    __builtin_amdgcn_fence(__ATOMIC_ACQUIRE, "agent"); asm volatile("s_waitcnt vmcnt(0)" ::: "memory"); MISC[24] = m_ | (1u << (bit_)); } \
                __syncthreads(); } } while (0)
            const int n_gin = lastl ? NB : NB * 8, n_cmid = lastl ? 0 : (NB * 4 + NCTX / 128), n_gout = lastl ? 0 : NB * 4;
            const int q1 = n_gin, q2 = q1 + 384, q3 = q2 + n_cmid, q4 = q3 + 384, q5 = q4 + n_gout, q6 = q5 + 128, q8 = q6 + NLAT / 128;
            static_assert(CV_UNITS == 384, "queue layout assumes 384 conversion units");
            gu32* qctr = ctl + CW_Q + l * 64;
            if (tid == 0) { MISC[16] = __hip_atomic_fetch_add(qctr, 1u, __ATOMIC_RELAXED, __HIP_MEMORY_SCOPE_AGENT); MISC[24] = 0u; }
            __syncthreads();
            int qpar = 0;
            for (;;) {
                const int qi = (int)MISC[16 + qpar];
                if (qi >= q8) break;
                if (tid == 0) MISC[16 + (qpar ^ 1)] = __hip_atomic_fetch_add(qctr, 1u, __ATOMIC_RELAXED, __HIP_MEMORY_SCOPE_AGENT);
                qpar ^= 1;
                int utype, uidx;
                if (qi < q1) { utype = 3; uidx = qi; }
                else if (qi < q2) { const int r = qi - q1; utype = (r & 1) ? 0 : 1; uidx = r >> 1; }
                else if (qi < q3) { const int r = qi - q2; if (r < NB * 4) { utype = 1; uidx = NB * 64 + r; } else { utype = 2; uidx = NLAT / 128 + (r - NB * 4); } }
                else if (qi < q4) { const int r = qi - q3; utype = (r & 1) ? 0 : 1; uidx = 192 + (r >> 1); }
                else if (qi < q5) { utype = 4; uidx = qi - q4; }
                else if (qi < q6) { utype = 1; uidx = 384 + (qi - q5); }
                else { utype = 2; uidx = qi - q6; }
                if (utype == 3) {
                    const int cb = lastl ? uidx : (uidx >> 3), pn = lastl ? 2 : (uidx & 7);
                    SchedOne S1; S1.pm = NLAT / 256 + cb; S1.pn = pn; S1.rowbytes = D * 2; S1.Bt = (const char*)(WinT + (size_t)l * INW * D); S1.btile = (size_t)256 * D * 2;
                    EpiProj E1{proj, (LAS const float*)(lds + L_ROPE)};
                    pg8::gemm_phase<EpiProj, SchedOne, false>(lds, (const char*)hx, D * 2, S1, E1);
                    DEP_PUBLISH(cproj + cb);
                    __syncthreads();
                } else if (utype == 4) {
                    const int cb = uidx >> 2, pn = uidx & 3;
                    DEP_ENSURE(8 + cb, cmix + cb, 6u);
                    SchedOne S1; S1.pm = NLAT / 256 + cb; S1.pn = pn; S1.rowbytes = D * 2; S1.Bt = (const char*)(WoutT + (size_t)l * D * D); S1.btile = (size_t)256 * D * 2;
                    EpiOut E1{xbuf, mod_l, (float*)(ws + WS_PSTAT)};
                    pg8::gemm_phase<EpiOut, SchedOne, false>(lds, (const char*)mix, D * 2, S1, E1);
                    __syncthreads();
                } else if (utype == 0) {
                    int tidb_ = threadIdx.x; asm volatile("" : "+v"(tidb_)); const int tid = tidb_, lane = tid & 63;
                    LAS float* scr = (LAS float*)(lds + wave * 9216);
                    convert_unit(kp->in[I_W1], kp->in[I_W3], kp->in[I_W2], W13T, W2T, l, uidx, wave, scr, lane);
                    __syncthreads();
                } else if (utype == 1) {
                    int tidb_ = threadIdx.x; asm volatile("" : "+v"(tidb_)); const int tid = tidb_, lane = tid & 63;
                    int b, nb, g, qrow0; unsigned cmask;
                    if (uidx < NB * 64) { b = uidx >> 6; nb = (uidx >> 1) & 31; g = uidx & 1; qrow0 = b * SEQ + nb * 128; cmask = 0x1fu & ~(nb == 0 ? 1u : 0u) & ~(nb == 31 ? 4u : 0u); }
                    else { const int v = uidx - NB * 64; b = v >> 2; nb = 0; g = v & 1; qrow0 = NLAT + b * CTXL + ((v >> 1) & 1) * 128; cmask = 0x18u; }
                    if (uidx >= NB * 64) DEP_ENSURE(b, cproj + b, need_proj);
                    const int r32 = lane & 31, hi_ = lane >> 5;
                    const int hh = 4 * g + (wave & 3), qs = 64 * (wave >> 2);
                    const int blk = (lane >> 4) & 1, qq = (lane & 15) >> 2, pp = lane & 3;
                    u32x4 kreg[2], vreg[2];
#define ATT_LOAD(c_) do { const int krow0_ = ((c_) < 3) ? (b * SEQ + (nb - 1 + (c_)) * 128) : (NLAT + b * CTXL + ((c_) - 3) * 128); \
                        _Pragma("unroll") for (int i_ = 0; i_ < 2; ++i_) { const int p_ = tid + 512 * i_; const bf16_t* src_ = proj + (size_t)(krow0_ + (p_ >> 3)) * INW + 512 + 64 * g + (p_ & 7) * 8; \
                            kreg[i_] = *(const u32x4*)src_; vreg[i_] = *(const u32x4*)(src_ + 128); } } while (0)
#define ATT_STORE(buf_) do { _Pragma("unroll") for (int i_ = 0; i_ < 2; ++i_) { const int p_ = tid + 512 * i_; \
                            *(LAS u32x4*)(lds + (buf_) * 36864 + (p_ >> 3) * 144 + (p_ & 7) * 16) = kreg[i_]; *(LAS u32x4*)(lds + (buf_) * 36864 + 18432 + (p_ >> 3) * 144 + (p_ & 7) * 16) = vreg[i_]; } } while (0)
                    int c = __builtin_ctz(cmask); cmask &= cmask - 1;
                    ATT_LOAD(c);
                    bf16x8 qf[2][4];
                    {
                        LAS unsigned char* qst = lds + 73728 + wave * 9216;
                        u32x4 qreg[8];
#pragma unroll
                        for (int it = 0; it < 8; ++it) qreg[it] = *(const u32x4*)(proj + (size_t)(qrow0 + qs + it * 8 + (lane >> 3)) * INW + hh * 64 + (lane & 7) * 8);
#pragma unroll
                        for (int it = 0; it < 8; ++it) *(LAS u32x4*)(qst + (it * 8 + (lane >> 3)) * 144 + (lane & 7) * 16) = qreg[it];
                        LDS_WAIT();
#pragma unroll
                        for (int qt = 0; qt < 2; ++qt)
#pragma unroll
                            for (int d0 = 0; d0 < 4; ++d0) qf[qt][d0] = *(const LAS bf16x8*)(qst + (32 * qt + r32) * 144 + (16 * d0 + 8 * hi_) * 2);
                    }
                    float mref[2], lrun[2]; f32x16 o[2][2];
                    const float sink2 = kp->in[I_SINK][l * 8 + hh] * LOG2E;
#pragma unroll
                    for (int qt = 0; qt < 2; ++qt) { mref[qt] = sink2; lrun[qt] = hi_ ? 0.f : 1.f;
#pragma unroll
                        for (int db = 0; db < 2; ++db)
#pragma unroll
                            for (int r = 0; r < 16; ++r) o[qt][db][r] = 0.f; }
                    ATT_STORE(0);
                    __syncthreads();
                    int buf = 0;
                    for (;;) {
                        const int cn = cmask ? __builtin_ctz(cmask) : -1;
                        if (cn >= 3) DEP_ENSURE(b, cproj + b, need_proj);
                        if (cn >= 0) ATT_LOAD(cn);
                        const int mtype = (c == 0) ? 1 : ((c == 2) ? 2 : 0);
                        const LAS unsigned char* Kl = lds + buf * 36864; const LAS unsigned char* Vl = Kl + 18432;
#pragma unroll 1
                        for (int kvt = 0; kvt < 4; ++kvt) {
                            if (mtype == 1 && 32 * kvt + 31 < qs) continue;
                            if (mtype == 2 && 32 * kvt > qs + 63) continue;
                            bf16x8 kf[4];
#pragma unroll
                            for (int d0 = 0; d0 < 4; ++d0) kf[d0] = *(const LAS bf16x8*)(Kl + (32 * kvt + r32) * 144 + (16 * d0 + 8 * hi_) * 2);
                            bf16x8 vf[2][2];
#pragma unroll
                            for (int db = 0; db < 2; ++db)
#pragma unroll
                                for (int ks = 0; ks < 2; ++ks) {
                                    const LAS unsigned char* p0 = Vl + (32 * kvt + 16 * ks + 4 * hi_ + qq) * 144 + (32 * db + 16 * blk + 4 * pp) * 2;
                                    const s16x4 t0 = __builtin_bit_cast(s16x4, __builtin_amdgcn_ds_read_tr16_b64_v4i16((LAS s16x4*)p0));
                                    const s16x4 t1 = __builtin_bit_cast(s16x4, __builtin_amdgcn_ds_read_tr16_b64_v4i16((LAS s16x4*)(p0 + 8 * 144)));
                                    vf[db][ks] = (bf16x8){t0[0], t0[1], t0[2], t0[3], t1[0], t1[1], t1[2], t1[3]};
                                }
#pragma unroll
                            for (int qt = 0; qt < 2; ++qt) {
                                const int i0 = qs + 32 * qt;
                                if (mtype == 1 && 32 * kvt + 31 < i0) continue;
                                if (mtype == 2 && 32 * kvt > i0 + 31) continue;
                                f32x16 sv;
#pragma unroll
                                for (int r = 0; r < 16; ++r) sv[r] = 0.f;
#pragma unroll
                                for (int d0 = 0; d0 < 4; ++d0) sv = __builtin_amdgcn_mfma_f32_32x32x16_bf16(kf[d0], qf[qt][d0], sv, 0, 0, 0);
                                const int iq = i0 + r32;
                                if (mtype != 0) {
#pragma unroll
                                    for (int r = 0; r < 16; ++r) { const int jj = 32 * kvt + (r & 3) + 8 * (r >> 2) + 4 * hi_;
                                        const bool ok = (mtype == 1) ? (jj >= iq) : (jj <= iq); sv[r] = ok ? sv[r] : -INFINITY; }
                                }
#pragma unroll
                                for (int r = 0; r < 16; ++r) sv[r] -= mref[qt];
                                float tmax = fmaxf(fmaxf(sv[0], sv[1]), fmaxf(sv[2], sv[3]));
#pragma unroll
                                for (int r = 4; r < 16; r += 4) tmax = fmaxf(tmax, fmaxf(fmaxf(sv[r], sv[r + 1]), fmaxf(sv[r + 2], sv[r + 3])));
                                if (__any(tmax > 8.0f)) {
                                    tmax = fmaxf(tmax, __shfl_xor(tmax, 32));
                                    const float dl = fmaxf(tmax, 0.f);
                                    mref[qt] += dl;
                                    const float f = __builtin_amdgcn_exp2f(-dl);
                                    lrun[qt] *= f;
#pragma unroll
                                    for (int r = 0; r < 16; ++r) sv[r] -= dl;
#pragma unroll
                                    for (int db = 0; db < 2; ++db)
#pragma unroll
                                        for (int r = 0; r < 16; ++r) o[qt][db][r] *= f;
                                }
                                float psum = 0.f;
#pragma unroll
                                for (int r = 0; r < 16; ++r) { sv[r] = __builtin_amdgcn_exp2f(sv[r]); psum += sv[r]; }
                                lrun[qt] += psum;
                                bf16x8 pf[2];
#pragma unroll
                                for (int ks = 0; ks < 2; ++ks) { u32x4 w; w.x = pk2(sv[8 * ks + 0], sv[8 * ks + 1]); w.y = pk2(sv[8 * ks + 2], sv[8 * ks + 3]); w.z = pk2(sv[8 * ks + 4], sv[8 * ks + 5]); w.w = pk2(sv[8 * ks + 6], sv[8 * ks + 7]); pf[ks] = __builtin_bit_cast(bf16x8, w); }
#pragma unroll
                                for (int db = 0; db < 2; ++db)
#pragma unroll
                                    for (int ks = 0; ks < 2; ++ks) o[qt][db] = __builtin_amdgcn_mfma_f32_32x32x16_bf16(vf[db][ks], pf[ks], o[qt][db], 0, 0, 0);
                            }
                        }
                        if (cn < 0) break;
                        ATT_STORE(buf ^ 1);
                        __syncthreads();
                        buf ^= 1; c = cn; cmask &= cmask - 1;
                    }
#undef ATT_LOAD
#undef ATT_STORE
                    LAS unsigned char* ost = lds + 73728 + wave * 4608;
#pragma unroll
                    for (int qt = 0; qt < 2; ++qt) {
                        float lt = lrun[qt]; lt += __shfl_xor(lt, 32);
                        const float inv = 1.0f / lt;
#pragma unroll
                        for (int db = 0; db < 2; ++db)
#pragma unroll
                            for (int rg = 0; rg < 4; ++rg) { u32x2 w; w.x = pk2(o[qt][db][4 * rg + 0] * inv, o[qt][db][4 * rg + 1] * inv); w.y = pk2(o[qt][db][4 * rg + 2] * inv, o[qt][db][4 * rg + 3] * inv);
                                *(LAS u32x2*)(ost + r32 * 144 + (32 * db + 8 * rg + 4 * hi_) * 2) = w; }
                        LDS_WAIT();
                        bf16_t* obase = mix + (size_t)(qrow0 + qs + 32 * qt) * D + hh * 64;
#pragma unroll
                        for (int it = 0; it < 4; ++it) { const int row = it * 8 + (lane >> 3), ch = lane & 7;
                            const u32x4 v = *(const LAS u32x4*)(ost + row * 144 + ch * 16); *(u32x4*)(obase + (size_t)row * D + ch * 8) = v; }
                        LDS_WAIT();
                    }
                    if (uidx >= NB * 64) DEP_PUBLISH(cmix + b);
                    __syncthreads();
                } else {
                    int tidb_ = threadIdx.x; asm volatile("" : "+v"(tidb_)); const int tid = tidb_, lane = tid & 63;
                    const int ch = uidx, row0 = ch * 128;
                    const int cb_loc = (ch - NLAT / 128) >> 1;
                    if (ch >= NLAT / 128) DEP_ENSURE(cb_loc, cproj + cb_loc, need_proj);
                    const int seqlen = (row0 < NLAT) ? SEQ : CTXL;
                    const int sbase = (row0 < NLAT) ? (row0 / SEQ) * SEQ : NLAT + ((row0 - NLAT) / CTXL) * CTXL;
                    {
                        const int c8 = (tid & 31) * 8, tg = tid >> 5;
                        const float* cw = kp->in[I_CONVW] + (size_t)l * 3 * 256;
                        const int t0 = row0 + tg * 8;
                        u32x4 ccv[10], cxv[10], cbv[8];
#pragma unroll
                        for (int i = 0; i < 10; ++i) {
                            int row = t0 - 1 + i; const bool ok = (row >= sbase) && (row < sbase + seqlen); row = ok ? row : t0;
                            ccv[i] = *(const u32x4*)(proj + (size_t)row * INW + 1024 + c8); cxv[i] = *(const u32x4*)(proj + (size_t)row * INW + 1280 + c8);
                            if (!ok) { ccv[i] = (u32x4){0u, 0u, 0u, 0u}; }
                        }
#pragma unroll
                        for (int i = 0; i < 8; ++i) cbv[i] = *(const u32x4*)(proj + (size_t)(t0 + i) * INW + 768 + c8);
                        float w0[8], w1[8], w2[8];
#pragma unroll
                        for (int j = 0; j < 8; ++j) { w0[j] = cw[c8 + j]; w1[j] = cw[256 + c8 + j]; w2[j] = cw[512 + c8 + j]; }
#define ZROW(Z_, i) do { const u32x4 cc = ccv[i], cx = cxv[i]; Z_[0] = bflo(cc.x) * bflo(cx.x); Z_[1] = bfhi(cc.x) * bfhi(cx.x); Z_[2] = bflo(cc.y) * bflo(cx.y); Z_[3] = bfhi(cc.y) * bfhi(cx.y); \
                            Z_[4] = bflo(cc.z) * bflo(cx.z); Z_[5] = bfhi(cc.z) * bfhi(cx.z); Z_[6] = bflo(cc.w) * bflo(cx.w); Z_[7] = bfhi(cc.w) * bfhi(cx.w); } while (0)
                        float zp[8], zc[8], zn[8];
                        ZROW(zp, 0); ZROW(zc, 1);
#pragma unroll
                        for (int tt = 0; tt < 8; ++tt) {
                            ZROW(zn, tt + 2);
                            const u32x4 cb = cbv[tt];
                            const float bb[8] = {bflo(cb.x), bfhi(cb.x), bflo(cb.y), bfhi(cb.y), bflo(cb.z), bfhi(cb.z), bflo(cb.w), bfhi(cb.w)};
                            float y[8];
#pragma unroll
                            for (int j = 0; j < 8; ++j) y[j] = bb[j] * (zp[j] * w0[j] + zc[j] * w1[j] + zn[j] * w2[j]);
                            u32x4 ov; ov.x = pk2(y[0], y[1]); ov.y = pk2(y[2], y[3]); ov.z = pk2(y[4], y[5]); ov.w = pk2(y[6], y[7]);
                            *(u32x4*)(mix + (size_t)(t0 + tt) * D + 512 + c8) = ov;
#pragma unroll
                            for (int j = 0; j < 8; ++j) { zp[j] = zc[j]; zc[j] = zn[j]; }
                        }
#undef ZROW
                    }
                    LAS unsigned char* Vg = lds;
                    {
                        const int t16 = lane & 15, kq = lane >> 4, tt = wave * 16 + t16;
                        const bf16_t* gp = proj + (size_t)(row0 + tt) * INW + 1792 + 64 * kq;
                        u32x4 gvv[8];
#pragma unroll
                        for (int i = 0; i < 8; ++i) gvv[i] = *(const u32x4*)(gp + 8 * i);
                        float vv[64]; float sm = 0.f, sq = 0.f;
#pragma unroll
                        for (int i = 0; i < 8; ++i) {
                            const unsigned wq[4] = {gvv[i].x, gvv[i].y, gvv[i].z, gvv[i].w};
#pragma unroll
                            for (int j = 0; j < 4; ++j) { const float a0 = gelu_tanh_f(bflo(wq[j])), a1 = gelu_tanh_f(bfhi(wq[j])); vv[8 * i + 2 * j] = a0; vv[8 * i + 2 * j + 1] = a1; sm += a0 + a1; sq += a0 * a0 + a1 * a1; }
                        }
                        sm += __shfl_xor(sm, 16); sm += __shfl_xor(sm, 32); sq += __shfl_xor(sq, 16); sq += __shfl_xor(sq, 32);
                        const float mu = sm * (1.0f / 256.0f);
                        const float rs = 1.0f / sqrtf(fmaxf(sq * (1.0f / 256.0f) - mu * mu, 0.f) + LN_EPS);
#pragma unroll
                        for (int i = 0; i < 8; ++i) {
                            u32x4 w; w.x = pk2((vv[8 * i + 0] - mu) * rs, (vv[8 * i + 1] - mu) * rs); w.y = pk2((vv[8 * i + 2] - mu) * rs, (vv[8 * i + 3] - mu) * rs);
                            w.z = pk2((vv[8 * i + 4] - mu) * rs, (vv[8 * i + 5] - mu) * rs); w.w = pk2((vv[8 * i + 6] - mu) * rs, (vv[8 * i + 7] - mu) * rs);
                            *(LAS u32x4*)(Vg + tt * 528 + (64 * kq + 8 * i) * 2) = w;
                        }
                    }
                    {
                        const int gg = wave >> 1, ph = wave & 1, r32 = lane & 31, hi_ = lane >> 5;
                        const int blk = (lane >> 4) & 1, qq = (lane & 15) >> 2, pp = lane & 3;
                        const bf16_t* wsg = gmw + ((size_t)(l * 4 + gg) * 128) * 128;
                        bf16x8 bfr[8][2];
#pragma unroll
                        for (int ks = 0; ks < 8; ++ks)
#pragma unroll
                            for (int pt = 0; pt < 2; ++pt) bfr[ks][pt] = *(const bf16x8*)(wsg + (size_t)(64 * ph + 32 * pt + r32) * 128 + 16 * ks + 8 * hi_);
                        u32x2 uu[2][2][4];
#pragma unroll
                        for (int pt = 0; pt < 2; ++pt)
#pragma unroll
                            for (int ct = 0; ct < 2; ++ct)
#pragma unroll
                                for (int rg = 0; rg < 4; ++rg) uu[pt][ct][rg] = *(const u32x2*)(proj + (size_t)(row0 + 64 * ph + 32 * pt + r32) * INW + 1536 + gg * 64 + 32 * ct + 8 * rg + 4 * hi_);
                        __syncthreads();
                        f32x16 sacc[2][2];
#pragma unroll
                        for (int pt = 0; pt < 2; ++pt)
#pragma unroll
                            for (int ct = 0; ct < 2; ++ct)
#pragma unroll
                                for (int r = 0; r < 16; ++r) sacc[pt][ct][r] = 0.f;
#pragma unroll
                        for (int ks = 0; ks < 8; ++ks) {
                            bf16x8 af[2];
#pragma unroll
                            for (int ct = 0; ct < 2; ++ct) {
                                const LAS unsigned char* p0 = Vg + (16 * ks + 8 * hi_ + qq) * 528 + (gg * 64 + 32 * ct + 16 * blk + 4 * pp) * 2;
                                const s16x4 t0 = __builtin_bit_cast(s16x4, __builtin_amdgcn_ds_read_tr16_b64_v4i16((LAS s16x4*)p0));
                                const s16x4 t1 = __builtin_bit_cast(s16x4, __builtin_amdgcn_ds_read_tr16_b64_v4i16((LAS s16x4*)(p0 + 4 * 528)));
                                af[ct] = (bf16x8){t0[0], t0[1], t0[2], t0[3], t1[0], t1[1], t1[2], t1[3]};
                            }
#pragma unroll
                            for (int pt = 0; pt < 2; ++pt)
#pragma unroll
                                for (int ct = 0; ct < 2; ++ct) sacc[pt][ct] = __builtin_amdgcn_mfma_f32_32x32x16_bf16(af[ct], bfr[ks][pt], sacc[pt][ct], 0, 0, 0);
                        }
#pragma unroll
                        for (int pt = 0; pt < 2; ++pt) {
                            const int p = 64 * ph + 32 * pt + r32, row = row0 + p;
                            const float bias = kp->in[I_GMBS][(l * 4 + gg) * 128 + p];
#pragma unroll
                            for (int ct = 0; ct < 2; ++ct)
#pragma unroll
                                for (int rg = 0; rg < 4; ++rg) {
                                    const int cc = gg * 64 + 32 * ct + 8 * rg + 4 * hi_;
                                    const u32x2 u2 = uu[pt][ct][rg];
                                    const float y0 = gelu_tanh_f(bflo(u2.x)) * (sacc[pt][ct][4 * rg + 0] + bias), y1 = gelu_tanh_f(bfhi(u2.x)) * (sacc[pt][ct][4 * rg + 1] + bias);
                                    const float y2 = gelu_tanh_f(bflo(u2.y)) * (sacc[pt][ct][4 * rg + 2] + bias), y3 = gelu_tanh_f(bfhi(u2.y)) * (sacc[pt][ct][4 * rg + 3] + bias);
                                    u32x2 w; w.x = pk2(y0, y1); w.y = pk2(y2, y3);
                                    *(u32x2*)(mix + (size_t)row * D + 768 + cc) = w;
                                }
                        }
                    }
                    if (ch >= NLAT / 128) DEP_PUBLISH(cmix + cb_loc);
                    __syncthreads();
                }
            }
#undef DEP_PUBLISH
#undef DEP_ENSURE
        }
        GRID_BAR(pb + 1);

        if (IN(pb + 2)) {
            PHASE_PTRS();
            SchedPlain S; S.nM = NLAT / 256; S.nN = 4; S.nX = 0; S.xpm0 = 0; S.xpn = 0; S.G = G; S.c = bx;
            S.rowbytes = D * 2; S.Bt = (const char*)(WoutT + (size_t)l * D * D); S.btile = (size_t)256 * D * 2;
            EpiOut E{xbuf, mod_l, (float*)(ws + WS_PSTAT)};
            pg8::gemm_phase<EpiOut, SchedPlain, false>(lds, (const char*)mix, D * 2, S, E);
        }
        GRID_BAR(pb + 2);

        if (IN(pb + 3)) {
            PHASE_PTRS();
            const int RB = lastl ? 128 : 136;
            LAS int* lcnt = (LAS int*)(lds + L_N1);
            LAS int* lbase = lcnt + 32;
            LAS int* rec = lbase + 32;
            const int r16 = lane & 15, kq = lane >> 4;
            for (int blk = bx; blk < nrow_l / RB; blk += G) {
                const int rbase = blk * RB;
                {
                    const unsigned char* wimg = ws + WS_WRIMG + (size_t)l * WRIMG_BYTES;
                    constexpr int NCH_ = WRIMG_BYTES / 1024;
#pragma unroll 1
                    for (int ci = wave; ci < NCH_; ci += 8)
                        __builtin_amdgcn_global_load_lds((const unsigned*)(wimg + (size_t)ci * 1024 + lane * 16), (LAS unsigned*)(lds + ci * 1024), 16, 0, 0);
                    if (tid < (WRIMG_BYTES - NCH_ * 1024) / 16) ((LAS u32x4*)(lds + NCH_ * 1024))[tid] = ((const u32x4*)(wimg + NCH_ * 1024))[tid];
                    asm volatile("s_waitcnt vmcnt(0)" ::: "memory");
                }
                if (tid < 32) lcnt[tid] = 0;
                __syncthreads();
                f32x4 lacc[2][3];
#pragma unroll
                for (int gi = 0; gi < 2; ++gi) {
#pragma unroll
                    for (int ob = 0; ob < 3; ++ob) lacc[gi][ob] = (f32x4){0.f, 0.f, 0.f, 0.f};
                    if (gi == 0 || RB > 128) {
                        const int row = (gi == 0) ? (rbase + 16 * wave + r16) : (rbase + 128 + (r16 & 7));
                        const bool wr_ok = (gi == 0) || (r16 < 8);
                        const int ks0 = (gi == 0) ? 0 : 4 * wave, ks1 = (gi == 0) ? 32 : 4 * wave + 4;
                        const bf16_t* xr = xbuf + (size_t)row * D + 8 * kq;
                        float s = 0.f, q = 0.f;
                        {
                            const f32x4* ps = (const f32x4*)((const float*)(ws + WS_PSTAT) + ((size_t)row * 32 + 8 * kq) * 2);
#pragma unroll
                            for (int j = 0; j < 4; ++j) { const f32x4 p = ps[j]; s += p[0] + p[2]; q += p[1] + p[3]; }
                        }
                        s += __shfl_xor(s, 16); s += __shfl_xor(s, 32); q += __shfl_xor(q, 16); q += __shfl_xor(q, 32);
                        const float mean = s * (1.0f / D);
                        const float var = fmaxf(q * (1.0f / D) - mean * mean, 0.f);
                        const float rstd = 1.0f / sqrtf(var + LN_EPS);
                        if (kq == 0 && wr_ok && (gi == 0 || wave == 0)) *(f32x2*)((float*)(ws + WS_RSTAT) + (size_t)row * 2) = (f32x2){mean, rstd};
                        const float* gcv = (const float*)(ws + WS_GC) + ((size_t)(l * 9 + ((row < NLAT) ? (row / SEQ) : 8)) * 2) * D + 8 * kq;
                        unsigned char* hrow = (unsigned char*)hx + (size_t)row * D + 8 * kq;
                        const LAS unsigned char* wb[3];
#pragma unroll
                        for (int ob = 0; ob < 3; ++ob) { const int oc = (16 * ob + r16 < 36) ? (16 * ob + r16) : 35; wb[ob] = lds + oc * WR_RS + 16 * kq; }
#pragma unroll 1
                        for (int ks4 = ks0; ks4 < ks1; ks4 += 4) {
                            u32x4 xw4[4]; f32x4 gg4[4][2], cc4[4][2];
#pragma unroll
                            for (int u = 0; u < 4; ++u) { const int c = 32 * (ks4 + u); xw4[u] = *(const u32x4*)(xr + c);
#pragma unroll
                                for (int e = 0; e < 2; ++e) { gg4[u][e] = *(const f32x4*)(gcv + c + 4 * e); cc4[u][e] = *(const f32x4*)(gcv + D + c + 4 * e); } }
#pragma unroll
                            for (int u = 0; u < 4; ++u) {
                                const int ks = ks4 + u, c = 32 * ks;
                                f32x4 hh[2];
                                const u32x4 xw = xw4[u];
#pragma unroll
                                for (int e = 0; e < 2; ++e) {
                                    const unsigned w0 = e ? xw.z : xw.x, w1 = e ? xw.w : xw.y;
                                    const f32x4 v = (f32x4){bflo(w0), bfhi(w0), bflo(w1), bfhi(w1)};
                                    hh[e] = (v - mean) * rstd * gg4[u][e] + cc4[u][e];
                                }
                                u32x4 hw, lw;
                                hw.x = pk2(hh[0][0], hh[0][1]); hw.y = pk2(hh[0][2], hh[0][3]); hw.z = pk2(hh[1][0], hh[1][1]); hw.w = pk2(hh[1][2], hh[1][3]);
                                lw.x = pk2(hh[0][0] - bflo(hw.x), hh[0][1] - bfhi(hw.x)); lw.y = pk2(hh[0][2] - bflo(hw.y), hh[0][3] - bfhi(hw.y));
                                lw.z = pk2(hh[1][0] - bflo(hw.z), hh[1][1] - bfhi(hw.z)); lw.w = pk2(hh[1][2] - bflo(hw.w), hh[1][3] - bfhi(hw.w));
                                if (wr_ok) { u32x2 h8; h8.x = pk4_fp8(hh[0][0], hh[0][1], hh[0][2], hh[0][3]); h8.y = pk4_fp8(hh[1][0], hh[1][1], hh[1][2], hh[1][3]); *(u32x2*)(hrow + c) = h8; }
                                const bf16x8 ahi = __builtin_bit_cast(bf16x8, hw), alo = __builtin_bit_cast(bf16x8, lw);
#pragma unroll
                                for (int ob = 0; ob < 3; ++ob) {
                                    const bf16x8 bh = *(const LAS bf16x8*)(wb[ob] + 64 * ks), bl = *(const LAS bf16x8*)(wb[ob] + WR_LO + 64 * ks);
                                    lacc[gi][ob] = __builtin_amdgcn_mfma_f32_16x16x32_bf16(ahi, bh, lacc[gi][ob], 0, 0, 0);
                                    lacc[gi][ob] = __builtin_amdgcn_mfma_f32_16x16x32_bf16(alo, bh, lacc[gi][ob], 0, 0, 0);
                                    lacc[gi][ob] = __builtin_amdgcn_mfma_f32_16x16x32_bf16(ahi, bl, lacc[gi][ob], 0, 0, 0);
                                }
                            }
                        }
                    }
                }
                PROBE_MARK(17 + l);
                __syncthreads();
                LAS float* lgt = (LAS float*)(lds + wave * 2368);
                LAS float* part = (LAS float*)(lds + 18944 + wave * 2368);
                LAS float* lgx = (LAS float*)(lds + 37888);
#pragma unroll
                for (int ob = 0; ob < 3; ++ob)
#pragma unroll
                    for (int i = 0; i < 4; ++i) { const int col = 16 * ob + r16; if (col < 36) { lgt[(4 * kq + i) * 37 + col] = lacc[0][ob][i]; part[(4 * kq + i) * 37 + col] = lacc[1][ob][i]; } }
                __syncthreads();
                if (RB > 128 && tid < 8 * 36) { const int rr = tid / 36, col = tid % 36; float a = 0.f;
#pragma unroll
                    for (int w = 0; w < 8; ++w) a += ((LAS float*)(lds + 18944 + w * 2368))[rr * 37 + col];
                    lgx[rr * 37 + col] = a; }
                __syncthreads();
#pragma unroll 1
                for (int gi = 0; gi < 2; ++gi) {
                    const bool act = (gi == 0) ? (lane < 16) : (RB > 128 && wave == 0 && lane < 8);
                    if (act) {
                        const int row = (gi == 0) ? (rbase + 16 * wave + lane) : (rbase + 128 + lane);
                        const LAS float* lr = (gi == 0) ? (lgt + lane * 37) : (lgx + lane * 37);
                        float gl[4];
#pragma unroll
                        for (int j = 0; j < 4; ++j) gl[j] = lr[j] + kp->in[I_BRG][l * 4 + j];
                        int gsel = 0; float gm = gl[0];
#pragma unroll
                        for (int j = 1; j < 4; ++j) if (gl[j] > gm) { gm = gl[j]; gsel = j; }
                        float gsum = 0.f;
#pragma unroll
                        for (int j = 0; j < 4; ++j) gsum += expf(gl[j] - gm);
                        const float pgrp = 1.0f / gsum;
                        float el[8];
#pragma unroll
                        for (int j = 0; j < 8; ++j) el[j] = lr[4 + 8 * gsel + j] + kp->in[I_BRE][l * 32 + gsel * 8 + j];
                        int i1 = 0; float e1 = el[0];
#pragma unroll
                        for (int j = 1; j < 8; ++j) if (el[j] > e1) { e1 = el[j]; i1 = j; }
                        int i2 = -1; float e2 = -INFINITY;
#pragma unroll
                        for (int j = 0; j < 8; ++j) if (j != i1 && el[j] > e2) { e2 = el[j]; i2 = j; }
                        const float ex = expf(e2 - e1);
                        const float ga = pgrp / (1.0f + ex), gb = pgrp * ex / (1.0f + ex);
                        const int ea = gsel * 8 + i1, eb = gsel * 8 + i2;
                        const int ra = __hip_atomic_fetch_add(&lcnt[ea], 1, __ATOMIC_RELAXED, __HIP_MEMORY_SCOPE_WORKGROUP);
                        const int rb2 = __hip_atomic_fetch_add(&lcnt[eb], 1, __ATOMIC_RELAXED, __HIP_MEMORY_SCOPE_WORKGROUP);
                        LAS int* rc = rec + ((wave * 2 + gi) * 16 + lane) * 4;
                        rc[0] = ea; rc[1] = ra; rc[2] = eb; rc[3] = rb2;
                        *(f32x2*)(gates + (size_t)row * 2) = (f32x2){ga, gb};
                    }
                }
                __syncthreads();
                if (tid < 32) lbase[tid] = (int)__hip_atomic_fetch_add(cnt_l + tid, (unsigned)lcnt[tid], __ATOMIC_RELAXED, __HIP_MEMORY_SCOPE_AGENT);
                __syncthreads();
#pragma unroll 1
                for (int gi = 0; gi < 2; ++gi) {
                    const bool act = (gi == 0) ? (lane < 16) : (RB > 128 && wave == 0 && lane < 8);
                    if (act) {
                        const int row = (gi == 0) ? (rbase + 16 * wave + lane) : (rbase + 128 + lane);
                        const LAS int* rc = rec + ((wave * 2 + gi) * 16 + lane) * 4;
                        const int ea = rc[0], ra = lbase[ea] + rc[1], eb = rc[2], rb2 = lbase[eb] + rc[3];
                        elist[(size_t)ea * NROW + ra] = row; elist[(size_t)eb * NROW + rb2] = row;
                        *(int4*)(tokinfo + (size_t)row * 4) = make_int4(ea, ra, eb, rb2);
                    }
                }
                __syncthreads();
            }
        }
        GRID_BAR(pb + 3);

        LAS int* tile_e = (LAS int*)(lds + L_TILE_E); LAS int* tile_r0 = (LAS int*)(lds + L_TILE_R0); LAS int* tile_j = (LAS int*)(lds + L_TILE_J);
        LAS int* pstart = (LAS int*)(lds + L_PSTART); LAS int* ecnt = (LAS int*)(lds + L_CNT); LAS int* ntile_p = (LAS int*)(lds + L_NT);
        if (IN(pb + 4) || IN(pb + 5) || IN(pb + 6)) {
            PHASE_PTRS();
            __syncthreads();
            if (tid < 64) {
                const int e = tid & 31;
                const int c = (int)__hip_atomic_load(cnt_l + e, __ATOMIC_RELAXED, __HIP_MEMORY_SCOPE_AGENT);
                const int nt_ = (c + 255) >> 8;
                int inc = nt_;
#pragma unroll
                for (int o = 1; o < 32; o <<= 1) { const int v = __shfl_up(inc, o, 32); if (e >= o) inc += v; }
                const int tb = inc - nt_;
                if (tid < 32) {
                    ecnt[e] = c; pstart[e] = tb * 256;
#pragma nounroll
                    for (int j = 0; j < nt_; ++j) { tile_e[tb + j] = e; tile_r0[tb + j] = (tb + j) * 256; tile_j[tb + j] = j; }
                    if (e == 31) ntile_p[0] = inc;
                }
            }
            __syncthreads();
        }

        if (IN(pb + 4)) {
            PHASE_PTRS();
            const int ntile = __builtin_amdgcn_readfirstlane(ntile_p[0]);
            LAS int* idx = (LAS int*)(lds + L_IDX);
            {
                int tok_[8];
#pragma unroll
                for (int i = 0; i < 8; ++i) {
                    const int L = i * G + bx; tok_[i] = 0;
                    if (L < 4 * ntile && tid < 256) { const int t = L >> 2, e = tile_e[t], j = tile_j[t], ce = ecnt[e]; const int rr = j * 256 + tid; tok_[i] = elist[(size_t)e * NROW + (rr < ce ? rr : 0)]; }
                }
#pragma unroll
                for (int i = 0; i < 8; ++i) { const int L = i * G + bx; if (L < 4 * ntile && tid < 256) idx[i * 256 + tid] = tok_[i] * D; }
            }
            __syncthreads();
            SchedMoe<true> S; S.ntile = ntile; S.G = G; S.c = bx; S.rowbytes = D; S.Bt = (const char*)W13T; S.btile = (size_t)256 * D; S.bexp = (size_t)1024 * D;
            S.tile_e = tile_e; S.tile_r0 = tile_r0; S.idx = idx;
            EpiH E{(unsigned char*)Hb};
            pg8::gemm_phase<EpiH, SchedMoe<true>, true>(lds, (const char*)hx, D, S, E);
        }
        GRID_BAR(pb + 4);

        if (IN(pb + 5)) {
            PHASE_PTRS();
            const int ntile = __builtin_amdgcn_readfirstlane(ntile_p[0]);
            SchedMoe<false> S; S.ntile = ntile; S.G = G; S.c = bx; S.rowbytes = DE; S.Bt = (const char*)W2T; S.btile = (size_t)256 * DE; S.bexp = (size_t)1024 * DE;
            S.tile_e = tile_e; S.tile_r0 = tile_r0; S.idx = nullptr;
            EpiY E{(unsigned char*)Yb};
            pg8::gemm_phase<EpiY, SchedMoe<false>, true>(lds, (const char*)Hb, DE, S, E);
        }
        GRID_BAR(pb + 5);

        if (IN(pb + 6)) {
            PHASE_PTRS();
            LAS float* Lg1 = (LAS float*)lds; LAS float* Lb1 = Lg1 + D; LAS float* Lg2 = Lb1 + D; LAS float* Lb2 = Lg2 + D;
            LAS float* Lgm = Lb2 + D; LAS float* Lshn = Lgm + 9 * D; LAS float* Lscn = Lshn + 9 * D;
            {
                const float* mod_n = modall + (size_t)(l + 1) * 9 * 6144;
                const int nch = 16 + 36 + (lastl ? 0 : 72);
#pragma unroll 1
                for (int ci = wave; ci < nch; ci += 8) {
                    const float* src; LAS float* dst;
                    if (ci < 16) { const int v = ci >> 2, qd = ci & 3; src = kp->in[v == 0 ? I_LN1G : (v == 1 ? I_LN1B : (v == 2 ? I_LN2G : I_LN2B))] + l * D + 256 * qd; dst = Lg1 + v * D + 256 * qd; }
                    else { const int r_ = ci - 16, arr = r_ / 36, rr = (r_ % 36) >> 2, qd = r_ & 3;
                        src = ((arr == 0) ? (mod_l + 5 * D) : (arr == 1 ? mod_n : mod_n + D)) + (size_t)rr * 6144 + 256 * qd; dst = ((arr == 0) ? Lgm : (arr == 1 ? Lshn : Lscn)) + rr * D + 256 * qd; }
                    __builtin_amdgcn_global_load_lds((const unsigned*)(src + 4 * lane), (LAS unsigned*)dst, 16, 0, 0);
                }
                asm volatile("s_waitcnt vmcnt(0)" ::: "memory");
            }
            __syncthreads();
            const float* rstat = (const float*)(ws + WS_RSTAT);
            int4 tiN[2]; f32x2 gtN[2], rsN[2];
#pragma unroll
            for (int e = 0; e < 2; ++e) { int rw = gw + e * NGW; rw = rw < nrow_l ? rw : gw; tiN[e] = *(const int4*)(tokinfo + (size_t)rw * 4); gtN[e] = *(const f32x2*)(gates + (size_t)rw * 2); rsN[e] = *(const f32x2*)(rstat + (size_t)rw * 2); }
            for (int rowA = gw; rowA < nrow_l; rowA += 2 * NGW) {
                int4 ti[2]; f32x2 gt[2], rs1[2]; int rows[2]; bool valid[2];
#pragma unroll
                for (int e = 0; e < 2; ++e) { ti[e] = tiN[e]; gt[e] = gtN[e]; rs1[e] = rsN[e]; rows[e] = rowA + e * NGW; valid[e] = rows[e] < nrow_l; if (!valid[e]) rows[e] = rowA; }
                u32x2 xv[2][4]; unsigned ya[2][4], yb[2][4];
#pragma unroll
                for (int e = 0; e < 2; ++e) {
                    const bf16_t* xr = xbuf + (size_t)rows[e] * D + 4 * lane;
                    const unsigned char* pa = (const unsigned char*)Yb + (size_t)(pstart[ti[e].x] + ti[e].y) * D + 4 * lane; const unsigned char* pb2 = (const unsigned char*)Yb + (size_t)(pstart[ti[e].z] + ti[e].w) * D + 4 * lane;
#pragma unroll
                    for (int j = 0; j < 4; ++j) { xv[e][j] = *(const u32x2*)(xr + 256 * j); ya[e][j] = *(const unsigned*)(pa + 256 * j); yb[e][j] = *(const unsigned*)(pb2 + 256 * j); }
                }
#pragma unroll
                for (int e = 0; e < 2; ++e) { int rw = rowA + (2 + e) * NGW; rw = rw < nrow_l ? rw : rowA; tiN[e] = *(const int4*)(tokinfo + (size_t)rw * 4); gtN[e] = *(const f32x2*)(gates + (size_t)rw * 2); rsN[e] = *(const f32x2*)(rstat + (size_t)rw * 2); }
#pragma unroll
                for (int e = 0; e < 2; ++e) {
                    const int row = rows[e];
                    const int mr = (row < NLAT) ? (row / SEQ) : 8;
                    f32x4 v[4]; float s = 0.f;
#pragma unroll
                    for (int j = 0; j < 4; ++j) {
                        const int c = 256 * j + 4 * lane;
                        const f32x4 xf = (f32x4){bflo(xv[e][j].x), bfhi(xv[e][j].x), bflo(xv[e][j].y), bfhi(xv[e][j].y)};
                        const f32x4 x1 = (xf - rs1[e][0]) * rs1[e][1] * *(const LAS f32x4*)(Lg1 + c) + *(const LAS f32x4*)(Lb1 + c), g2 = *(const LAS f32x4*)(Lgm + mr * D + c);
                        const int a = (int)ya[e][j], b = (int)yb[e][j]; const float ga = gt[e][0] * (1.0f / Y8_SCALE), gb = gt[e][1] * (1.0f / Y8_SCALE);
                        f32x4 y; y[0] = ga * __builtin_amdgcn_cvt_f32_fp8(a, 0) + gb * __builtin_amdgcn_cvt_f32_fp8(b, 0); y[1] = ga * __builtin_amdgcn_cvt_f32_fp8(a, 1) + gb * __builtin_amdgcn_cvt_f32_fp8(b, 1);
                        y[2] = ga * __builtin_amdgcn_cvt_f32_fp8(a, 2) + gb * __builtin_amdgcn_cvt_f32_fp8(b, 2); y[3] = ga * __builtin_amdgcn_cvt_f32_fp8(a, 3) + gb * __builtin_amdgcn_cvt_f32_fp8(b, 3);
                        v[j] = ALPHA * x1 + g2 * y;
                        s += (v[j][0] + v[j][1]) + (v[j][2] + v[j][3]);
                    }
                    const float mean = wave_sum(s) * (1.0f / D); float s2 = 0.f;
#pragma unroll
                    for (int j = 0; j < 4; ++j) { v[j] = v[j] - mean; s2 += (v[j][0] * v[j][0] + v[j][1] * v[j][1]) + (v[j][2] * v[j][2] + v[j][3] * v[j][3]); }
                    const float rstd = 1.0f / sqrtf(wave_sum(s2) * (1.0f / D) + LN_EPS);
                    if (valid[e]) {
#pragma unroll
                        for (int j = 0; j < 4; ++j) {
                            const int c = 256 * j + 4 * lane;
                            const f32x4 x2 = v[j] * rstd * *(const LAS f32x4*)(Lg2 + c) + *(const LAS f32x4*)(Lb2 + c);
                            if (lastl) *(f32x4*)(kp->out + (size_t)row * D + c) = x2;
                            if (!lastl) {
                                u32x2 wx; wx.x = pk2(x2[0], x2[1]); wx.y = pk2(x2[2], x2[3]); *(u32x2*)(xbuf + (size_t)row * D + c) = wx;
                                const f32x4 hn = x2 * (1.0f + *(const LAS f32x4*)(Lscn + mr * D + c)) + *(const LAS f32x4*)(Lshn + mr * D + c);
                                u32x2 w; w.x = pk2(hn[0], hn[1]); w.y = pk2(hn[2], hn[3]);
                                *(u32x2*)(hx + (size_t)row * D + c) = w;
                            }
                        }
                    }
                }
            }
        }
        if (!lastl) GRID_BAR(pb + 6); else PROBE_MARK(pb + 6);
    }
#if defined(PROBE_A)
    if (blockIdx.x == 0) { const unsigned long long tgt = pr_a + (pr_b / 2000ull) * 400000ull    , t0_ = __builtin_amdgcn_s_memrealtime();
        while (__builtin_amdgcn_s_memrealtime() - t0_ < tgt) __builtin_amdgcn_s_sleep(64); }
#endif
#undef IN
#undef GRID_BAR
}

extern "C" void kernel_launch(void* const* d_in, const int* in_sizes, int n_in, void* d_out, int out_size, void* d_ws, size_t ws_size, hipStream_t stream) {
    static int grid = 0;
    if (grid == 0) {
        if (n_in != 23 || out_size != NLAT * D || ws_size < WS_END) { fprintf(stderr, "kernel_launch: unexpected shapes (n_in %d out %d ws %zu)\n", n_in, out_size, ws_size); grid = -1; return; }
        int dev = 0, cus = 0, per_cu = 0;
        if (hipGetDevice(&dev) != hipSuccess || hipDeviceGetAttribute(&cus, hipDeviceAttributeMultiprocessorCount, dev) != hipSuccess) { grid = -1; return; }
        if (hipFuncSetAttribute((const void*)fwd_kernel, hipFuncAttributeMaxDynamicSharedMemorySize, LDS_BYTES) != hipSuccess) { fprintf(stderr, "kernel_launch: hipFuncSetAttribute failed\n"); grid = -1; return; }
        if (hipOccupancyMaxActiveBlocksPerMultiprocessor(&per_cu, (const void*)fwd_kernel, 512, LDS_BYTES) != hipSuccess || per_cu < 1) { fprintf(stderr, "kernel_launch: occupancy query says %d\n", per_cu); }
        (void)hipGetLastError();
        grid = cus;
    }
    if (grid < 0) return;
    if (hipMemsetAsync((char*)d_ws + WS_CTL, 0, CTL_ZERO_BYTES, stream) != hipSuccess) return;
    Args a{};
    for (int i = 0; i < 23; ++i) a.in[i] = (const float*)d_in[i];
    a.out = (float*)d_out; a.ws = (unsigned char*)d_ws;
#if MK_N_LAUNCHES == 1
    a.ph_lo = 0; a.ph_hi = NPH;
    hipLaunchKernelGGL(fwd_kernel, dim3(grid), dim3(512), LDS_BYTES, stream, a);
#else
    for (int p = 0; p < NPH; ++p) { a.ph_lo = p; a.ph_hi = p + 1; hipLaunchKernelGGL(fwd_kernel, dim3(grid), dim3(512), LDS_BYTES, stream, a); }
#endif
}
```

```cpp
#include <hip/hip_runtime.h>
#include <cstdio>
#include <cstdint>

#ifndef MK_N_LAUNCHES
#define MK_N_LAUNCHES 1
#endif

#define LAS __attribute__((address_space(3)))
#define GAS __attribute__((address_space(1)))
typedef unsigned short bf16_t;
typedef short bf16x8 __attribute__((ext_vector_type(8)));
typedef short s16x4 __attribute__((ext_vector_type(4)));
typedef float f32x2 __attribute__((ext_vector_type(2)));
typedef float f32x4 __attribute__((ext_vector_type(4)));
typedef float f32x16 __attribute__((ext_vector_type(16)));
typedef unsigned u32x2 __attribute__((ext_vector_type(2)));
typedef unsigned u32x4 __attribute__((ext_vector_type(4)));
typedef GAS unsigned gu32;

constexpr int D = 1024, NB = 8, SEQ = 4096, CTXL = 256, DEPTH = 2;
constexpr int NLAT = NB * SEQ, NCTX = NB * CTXL, NROW = NLAT + NCTX;
constexpr int INW = 2048, NE = 32, DE = 512;
constexpr int MAXSLOT = 77824;
constexpr float ALPHA = 1.4142135623730951f;
constexpr float LN_EPS = 1e-6f;
constexpr float LOG2E = 1.4426950408889634f;
constexpr float QSCALE = 0.125f * LOG2E;

constexpr size_t MiB = 1u << 20;
constexpr size_t WS_CTL = 0, CTL_ZERO_BYTES = 64 * 1024;
constexpr size_t WS_MOD = 1 * MiB;
constexpr size_t WS_ROPE = 1 * MiB + 512 * 1024;
constexpr size_t WS_GMW = 1 * MiB + 768 * 1024;
constexpr size_t WS_TOKINFO = 2 * MiB;
constexpr size_t WS_GATES = 3 * MiB;
constexpr size_t WS_WRIMG = 3 * MiB + 512 * 1024;
constexpr size_t WS_LIST = 4 * MiB;
constexpr size_t WS_PSTAT = 550 * MiB;
constexpr size_t WS_RSTAT = 559 * MiB;
constexpr size_t WS_GC = 560 * MiB;
constexpr size_t WS_WIN = 10 * MiB;
constexpr size_t WS_WOUT = 18 * MiB;
constexpr size_t WS_W13 = 22 * MiB;
constexpr size_t WS_W2 = 86 * MiB;
constexpr size_t WS_HX = 118 * MiB;
constexpr size_t WS_XBUF = 186 * MiB;
constexpr size_t WS_PROJ = 322 * MiB;
constexpr size_t WS_MIX = 458 * MiB;
constexpr size_t WS_H = 322 * MiB;
constexpr size_t WS_Y = 398 * MiB;
constexpr size_t WS_END = 561 * MiB;
static_assert(WS_H + (size_t)MAXSLOT * DE * 2 <= WS_Y && WS_Y + (size_t)MAXSLOT * D * 2 <= WS_PSTAT && WS_PSTAT + (size_t)NROW * 256 <= WS_RSTAT, "ws map");
static_assert(WS_PROJ + (size_t)NROW * INW * 2 <= WS_MIX && WS_MIX + (size_t)NROW * D * 2 <= WS_PSTAT, "ws map");
static_assert(WS_LIST + (size_t)NE * NROW * 4 <= WS_WIN, "ws map");
constexpr int CW_BAR = 4096;
constexpr int CW_CNT = 8192;
constexpr int CW_Q = 8448;
constexpr int CW_DEP = 8704;
constexpr int CW_TMO = 0;
static_assert((CW_Q + 2 * 64) * 4 <= (int)CTL_ZERO_BYTES && (CW_BAR + 3456) * 4 <= (int)CTL_ZERO_BYTES, "control words inside the per-call memset");

constexpr int LDS_BYTES = 163840;
constexpr int RING_BYTES = 131072;
constexpr int L_TILE_E = 131072, L_TILE_R0 = L_TILE_E + 1280, L_TILE_J = L_TILE_R0 + 1280, L_PSTART = L_TILE_J + 1280, L_CNT = L_PSTART + 128, L_NT = L_CNT + 128;
constexpr int L_ROPE = 131072;
constexpr int L_IDX = 131072 + 8192;
constexpr int WR_RS = 2064, WR_LO = 36 * WR_RS, WRIMG_BYTES = 2 * WR_LO;
constexpr int L_N1 = 149504;
constexpr int MISC_OFF = LDS_BYTES - 256;

typedef __bf16 bf16x2_t __attribute__((ext_vector_type(2)));
__device__ __forceinline__ unsigned pk2(float lo, float hi) { f32x2 v = {lo, hi}; const bf16x2_t b = __builtin_convertvector(v, bf16x2_t); return __builtin_bit_cast(unsigned, b); }
__device__ __forceinline__ unsigned f2bf(float f) { return pk2(f, 0.f) & 0xffffu; }
constexpr float W8_SCALE = 64.0f, H8_SCALE = 8.0f, Y8_SCALE = 64.0f;
__device__ __forceinline__ float clamp8(float x) { return fminf(fmaxf(x, -448.0f), 448.0f); }
__device__ __forceinline__ unsigned pk4_fp8(float a, float b, float c, float d) {
    int w = __builtin_amdgcn_cvt_pk_fp8_f32(clamp8(a), clamp8(b), 0, false); w = __builtin_amdgcn_cvt_pk_fp8_f32(clamp8(c), clamp8(d), w, true); return (unsigned)w; }
__device__ __forceinline__ float bf2f(unsigned short b) { return __builtin_bit_cast(float, ((unsigned)b) << 16); }
__device__ __forceinline__ float bflo(unsigned w) { return __builtin_bit_cast(float, w << 16); }
__device__ __forceinline__ float bfhi(unsigned w) { return __builtin_bit_cast(float, w & 0xffff0000u); }
__device__ __forceinline__ float wave_sum(float v) {
#pragma unroll
    for (int o = 1; o < 64; o <<= 1) v += __shfl_xor(v, o);
    return v;
}
__device__ __forceinline__ float silu_f(float x) { return x * __builtin_amdgcn_rcpf(1.0f + __expf(-x)); }
__device__ __forceinline__ float gelu_tanh_f(float x) {
    const float z2 = 1.5957691216057308f * (x + 0.044715f * x * x * x);
    return x * __builtin_amdgcn_rcpf(1.0f + __expf(-z2));
}
#define LDS_WAIT() asm volatile("s_waitcnt lgkmcnt(0)" ::: "memory")
#define VM_WAIT() asm volatile("s_waitcnt vmcnt(0)" ::: "memory")

#define XB_TMO      128
#define XB_XCNT(j)  (256  + 64 * (j))
#define XB_XSUB(j)  (1280 + 64 * (j))
#define XB_XGEN(j)  (2304 + 64 * (j))
#define XB_TOP      3328
#define XB_TOPGEN   3392
#define XCD_BAR_WORDS 3456
#define XB_SPIN_CAP (1u << 18)
__device__ __forceinline__ unsigned xb_ld(unsigned* p)              { return __hip_atomic_load(p, __ATOMIC_RELAXED, __HIP_MEMORY_SCOPE_AGENT); }
__device__ __forceinline__ unsigned xb_add(unsigned* p, unsigned v) { return __hip_atomic_fetch_add(p, v, __ATOMIC_RELAXED, __HIP_MEMORY_SCOPE_AGENT); }
__device__ __forceinline__ unsigned xb_xcc_id() { return (unsigned)__builtin_amdgcn_s_getreg((3 << 11) | 20) & 0xFu; }
#define XB_SPIN(cond, bar) do { unsigned _sp = 0; while (cond) { __builtin_amdgcn_s_sleep(1); \
    if ((++_sp & 255u) == 0u) { if (xb_ld(&(bar)[XB_TMO])) break; if (_sp > XB_SPIN_CAP) { atomicAdd(&(bar)[XB_TMO], 1u); break; } } } } while (0)
struct XcdBarrier { unsigned* bar; unsigned x; volatile LAS unsigned* st; };
__device__ __forceinline__ XcdBarrier xcd_barrier_post(unsigned* bar, volatile LAS unsigned* st) {
    XcdBarrier b; b.bar = bar; b.x = xb_xcc_id(); b.st = st;
    if (threadIdx.x == 0) (void)xb_add(&bar[XB_XCNT(b.x)], 1u);
    return b;
}
__device__ __forceinline__ void xcd_barrier_complete(unsigned* bar, unsigned x, unsigned& nloc, unsigned& nx) {
    const unsigned G = gridDim.x * gridDim.y * gridDim.z;
    unsigned sum, cnt, mine, sp = 0u;
    for (;;) {
        sum = 0u; cnt = 0u; mine = 0u;
#pragma unroll
        for (unsigned j = 0; j < 16; ++j) { const unsigned c = xb_ld(&bar[XB_XCNT(j)]); sum += c; cnt += (c > 0u) ? 1u : 0u; mine = (j == x) ? c : mine; }
        if (sum == G) break;
        __builtin_amdgcn_s_sleep(1);
        if ((++sp & 255u) == 0u) { if (xb_ld(&bar[XB_TMO])) break; if (sp > XB_SPIN_CAP) { atomicAdd(&bar[XB_TMO], 1u); break; } }
    }
    nloc = mine > 0u ? mine : 1u; nx = cnt > 0u ? cnt : 1u;
}
__device__ __forceinline__ void xcd_barrier(const XcdBarrier& b) {
    asm volatile("s_waitcnt vmcnt(0)" ::: "memory");
    __syncthreads();
    if (threadIdx.x == 0) {
        unsigned* bar = b.bar;
        __builtin_amdgcn_s_waitcnt(0);
        unsigned nloc = b.st[0], nx = b.st[1];
        if (nloc == 0u) { xcd_barrier_complete(bar, b.x, nloc, nx); b.st[0] = nloc; b.st[1] = nx; }
        const unsigned old = xb_add(&bar[XB_XSUB(b.x)], 1u);
        const unsigned gen = old / nloc;
        if (old + 1u == (gen + 1u) * nloc) {
            __builtin_amdgcn_fence(__ATOMIC_RELEASE, "agent");
            asm volatile("s_waitcnt vmcnt(0)" ::: "memory");
            const unsigned og = xb_add(&bar[XB_TOP], 1u);
            const unsigned tg = og / nx;
            if (og + 1u == (tg + 1u) * nx) xb_add(&bar[XB_TOPGEN], 1u);
            else XB_SPIN(xb_ld(&bar[XB_TOPGEN]) == tg, bar);
            __builtin_amdgcn_fence(__ATOMIC_ACQUIRE, "agent");
            xb_add(&bar[XB_XGEN(b.x)], 1u);
            asm volatile("s_waitcnt vmcnt(0)" ::: "memory");
        } else {
            XB_SPIN(xb_ld(&bar[XB_XGEN(b.x)]) == gen, bar);
            __builtin_amdgcn_fence(__ATOMIC_ACQUIRE, "agent");
            asm volatile("s_waitcnt vmcnt(0)" ::: "memory");
        }
    }
    __syncthreads();
}

namespace pg8 {
constexpr int BM = 256, BK = 64, HALF = 128, HTB = HALF * BK * 2, STAGE_BYTES = 8 * HTB, NXCD = 8, WGM = 8;
__device__ __forceinline__ int lds_byte(int r, int c) { const int st = (r >> 4) * 2 + (c >> 5), rr = r & 15, cc = c & 31, ob = rr * 64 + cc * 2; return st * 1024 + (ob ^ (((ob >> 9) & 1) << 5)); }
__device__ __forceinline__ void stage_rc(int b, int& R, int& C) { const int st = b / 1024, sb = b % 1024, swz = sb ^ (((sb >> 9) & 1) << 5); R = (st >> 1) * 16 + swz / 64; C = (st & 1) * 32 + (swz % 64) / 2; }

__device__ __forceinline__ int perm32(int rho) { const int n = rho >> 4, i = rho & 15; return 8 * (i >> 2) + 4 * n + (i & 3); }
struct Unit { int pm, pn, e, r0, slot; };
__device__ __forceinline__ void swz_tile(int wgid, int nM, int nN, int& pm, int& pn) {
    const int nwg = nM * nN;
    { const int q = nwg / NXCD, r = nwg % NXCD, xcd = wgid % NXCD, off = wgid / NXCD; wgid = (xcd < r ? xcd * (q + 1) : r * (q + 1) + (xcd - r) * q) + off; }
    const int nig = WGM * nN, gid = wgid / nig, fm = gid * WGM, gsz = (nM - fm) < WGM ? (nM - fm) : WGM;
    pm = fm + ((wgid % nig) % gsz); pn = (wgid % nig) / gsz;
}

typedef int v8i_t __attribute__((ext_vector_type(8)));
__device__ __forceinline__ int f8_byte(int r, int kq) { const int rr = r & 15; return ((r >> 4) * 2 + (kq >> 1)) * 1024 + ((rr * 64 + (kq & 1) * 32) ^ (((rr >> 3) & 1) << 5)); }
template <class Epi, class Sched, bool FP8>
__device__ __forceinline__ void gemm_phase(LAS unsigned char* lds, const char* Abase, const int KB, const Sched& S, const Epi& E) {
    int tid = threadIdx.x; asm volatile("" : "+v"(tid));
    const int wid = __builtin_amdgcn_readfirstlane(tid >> 6), lane = tid & 63, wr = wid >> 2, wc = wid & 3, fr = lane & 15, fq = lane >> 4;
    const int nt = KB / 128;
    unsigned voffB[2];
#pragma unroll
    for (int i = 0; i < 2; ++i) { int R_, C_; stage_rc(tid * 16 + i * 8192, R_, C_); const int Rb_ = Epi::PERM ? ((R_ & ~31) + perm32(R_ & 31)) : R_; voffB[i] = (unsigned)(Rb_ * KB + C_ * 2); }
#define PG8_ROWOFFS(U, o00, o01, o10, o11) do { int t_ = tid; asm volatile("" : "+v"(t_)); int R0_, C0_, R1_, C1_; stage_rc(t_ * 16, R0_, C0_); stage_rc(t_ * 16 + 8192, R1_, C1_); \
        o00 = S.a_rowoff(U, R0_) + C0_ * 2; o01 = S.a_rowoff(U, R1_) + C1_ * 2; o10 = S.a_rowoff(U, HALF + R0_) + C0_ * 2; o11 = S.a_rowoff(U, HALF + R1_) + C1_ * 2; } while (0)
    const size_t kstep = (size_t)(BK * 2);
    const size_t hstep = (size_t)HALF * KB;
    const unsigned ldsw = (unsigned)wid * 1024u;
    const int aoff = FP8 ? f8_byte(wr * 64 + fr, fq) : lds_byte(wr * 64 + fr, fq * 8), boff = FP8 ? f8_byte(wc * 32 + fr, fq) : lds_byte(wc * 32 + fr, fq * 8);
    constexpr int FSTEP = FP8 ? 16 : 1024;
#define PG8_SA(b, h) (((b) * 2 + (h)) * HTB)
#define PG8_SB(b, h) ((4 + (b) * 2 + (h)) * HTB)
#define PG8_STAGE_B(bufoff, gbase) do { _Pragma("unroll") for (int _i = 0; _i < 2; ++_i) \
        __builtin_amdgcn_global_load_lds((const unsigned*)((const char*)(gbase) + voffB[_i]), (LAS unsigned*)(lds + (bufoff) + ldsw + _i * 8192), 16, 0, 0); } while (0)
#define PG8_STAGE_A(bufoff, gbase, o0, o1) do { \
        __builtin_amdgcn_global_load_lds((const unsigned*)((const char*)(gbase) + (o0)), (LAS unsigned*)(lds + (bufoff) + ldsw), 16, 0, 0); \
        __builtin_amdgcn_global_load_lds((const unsigned*)((const char*)(gbase) + (o1)), (LAS unsigned*)(lds + (bufoff) + ldsw + 8192), 16, 0, 0); } while (0)
typedef int v4i_t __attribute__((ext_vector_type(4)));
#define PG8_LDA(dst, b, h) do { _Pragma("unroll") for (int m = 0; m < 4; ++m) { dst[m].lo = *(const LAS v4i_t*)(lds + PG8_SA(b, h) + aoff + m * 2048); dst[m].hi = *(const LAS v4i_t*)(lds + PG8_SA(b, h) + aoff + m * 2048 + FSTEP); } } while (0)
#define PG8_LDB(dst, b, h) do { _Pragma("unroll") for (int n = 0; n < 2; ++n) { dst[n].lo = *(const LAS v4i_t*)(lds + PG8_SB(b, h) + boff + n * 2048); dst[n].hi = *(const LAS v4i_t*)(lds + PG8_SB(b, h) + boff + n * 2048 + FSTEP); } } while (0)
#define PG8_MMA(ai, bj, At, Bt) do { __builtin_amdgcn_s_setprio(1); _Pragma("unroll") for (int m = 0; m < 4; ++m) _Pragma("unroll") for (int n = 0; n < 2; ++n) { \
        if constexpr (FP8) asm volatile("v_mfma_f32_16x16x128_f8f6f4 %0, %1, %2, %0" : "+v"(acc[ai][bj][m][n]) : "v"(Bt[n]), "v"(At[m]));   \
        else { const v4i_t bl_ = Bt[n].lo, bh_ = Bt[n].hi, al_ = At[m].lo, ah_ = At[m].hi;     \
               acc[ai][bj][m][n] = __builtin_amdgcn_mfma_f32_16x16x32_bf16(__builtin_bit_cast(bf16x8, bl_), __builtin_bit_cast(bf16x8, al_), acc[ai][bj][m][n], 0, 0, 0); \
               acc[ai][bj][m][n] = __builtin_amdgcn_mfma_f32_16x16x32_bf16(__builtin_bit_cast(bf16x8, bh_), __builtin_bit_cast(bf16x8, ah_), acc[ai][bj][m][n], 0, 0, 0); } } __builtin_amdgcn_s_setprio(0); } while (0)
#define PG8_WAIT_V(n) asm volatile("s_waitcnt vmcnt(" #n ")" ::: "memory")
#define PG8_WAIT_L(n) asm volatile("s_waitcnt lgkmcnt(" #n ")" ::: "memory")
#define PG8_BAR __builtin_amdgcn_s_barrier()
#define PG8_SCHED __builtin_amdgcn_sched_barrier(0)
    Unit cur, nxt; int ui = 0;
    if (!S.next(0, cur)) return;
    f32x4 acc[2][2][4][2];
#pragma unroll
    for (int a = 0; a < 2; ++a)
#pragma unroll
        for (int b = 0; b < 2; ++b)
#pragma unroll
            for (int m = 0; m < 4; ++m)
#pragma unroll
                for (int n = 0; n < 2; ++n) acc[a][b][m][n] = (f32x4){0.f, 0.f, 0.f, 0.f};
    v8i_t At[4], B0[2], B1[2];
    unsigned c00, c01, c10, c11, n00, n01, n10, n11;
    PG8_ROWOFFS(cur, c00, c01, c10, c11);
    const char* cB = S.b_ptr(cur);
    const char* cA = Abase;
    PG8_STAGE_B(PG8_SB(0, 0), cB); PG8_STAGE_B(PG8_SB(0, 1), cB + hstep); PG8_STAGE_A(PG8_SA(0, 0), cA, c00, c01); PG8_STAGE_A(PG8_SA(0, 1), cA, c10, c11);
    if (wr == 1) PG8_BAR;
    PG8_WAIT_V(2); PG8_BAR;
    PG8_STAGE_B(PG8_SB(1, 0), cB + kstep); PG8_STAGE_A(PG8_SA(1, 0), cA + kstep, c00, c01); PG8_STAGE_B(PG8_SB(1, 1), cB + hstep + kstep);
    PG8_WAIT_V(6); PG8_BAR;
    for (;;) {
        const bool has_next = S.next(ui + 1, nxt);
        const char* nB = has_next ? S.b_ptr(nxt) : cB;
        if (has_next) { PG8_ROWOFFS(nxt, n00, n01, n10, n11); }
        else { n00 = c00; n01 = c01; n10 = c10; n11 = c11; }
#pragma nounroll
        for (int t = 0; t < nt; t += 2) {
            const bool last = (t == nt - 2);
            const char* a1 = cA + (size_t)(t + 1) * kstep;
            const char* a2 = last ? cA : cA + (size_t)(t + 2) * kstep; const char* b2 = last ? nB : cB + (size_t)(t + 2) * kstep;
            const char* a3 = a2 + kstep; const char* b3 = b2 + kstep;
            const unsigned x00 = last ? n00 : c00, x01 = last ? n01 : c01, x10 = last ? n10 : c10, x11 = last ? n11 : c11;
            PG8_LDB(B0, 0, 0); PG8_LDB(B1, 0, 1); PG8_SCHED; PG8_LDA(At, 0, 0); PG8_STAGE_A(PG8_SA(1, 1), a1, c10, c11);
            PG8_WAIT_V(8); PG8_WAIT_L(0); PG8_BAR; PG8_MMA(0, 0, At, B0); PG8_MMA(0, 1, At, B1); PG8_BAR; PG8_SCHED;
            PG8_LDA(At, 0, 1); PG8_STAGE_B(PG8_SB(0, 0), b2); PG8_STAGE_B(PG8_SB(0, 1), b2 + hstep); PG8_STAGE_A(PG8_SA(0, 0), a2, x00, x01);
            PG8_WAIT_V(8); PG8_WAIT_L(0); PG8_BAR; PG8_MMA(1, 0, At, B0); PG8_MMA(1, 1, At, B1); PG8_BAR; PG8_SCHED;
            PG8_LDB(B0, 1, 0); PG8_LDB(B1, 1, 1); PG8_SCHED; PG8_LDA(At, 1, 0); PG8_STAGE_A(PG8_SA(0, 1), a2, x10, x11);
            PG8_WAIT_V(8); PG8_WAIT_L(0); PG8_BAR; PG8_MMA(0, 0, At, B0); PG8_MMA(0, 1, At, B1); PG8_BAR; PG8_SCHED;
            PG8_LDA(At, 1, 1); PG8_STAGE_B(PG8_SB(1, 0), b3); PG8_STAGE_B(PG8_SB(1, 1), b3 + hstep); PG8_STAGE_A(PG8_SA(1, 0), a3, x00, x01);
            PG8_WAIT_V(8); PG8_WAIT_L(0); PG8_BAR; PG8_MMA(1, 0, At, B0); PG8_MMA(1, 1, At, B1); PG8_BAR; PG8_SCHED;
        }
        if constexpr (FP8) {
#pragma unroll
            for (int a_ = 0; a_ < 2; ++a_)
#pragma unroll
                for (int b_ = 0; b_ < 2; ++b_)
                    asm volatile("s_nop 15" : "+v"(acc[a_][b_][0][0]), "+v"(acc[a_][b_][0][1]), "+v"(acc[a_][b_][1][0]), "+v"(acc[a_][b_][1][1]), "+v"(acc[a_][b_][2][0]), "+v"(acc[a_][b_][2][1]), "+v"(acc[a_][b_][3][0]), "+v"(acc[a_][b_][3][1]));
        }
        if (wr == 0) PG8_BAR;
        { int fr_ = fr, fq_ = fq; asm volatile("" : "+v"(fr_), "+v"(fq_));
          E(acc, cur, wr, wc, fr_, fq_); }
        if (!has_next) break;
#pragma unroll
        for (int a = 0; a < 2; ++a)
#pragma unroll
            for (int b = 0; b < 2; ++b)
#pragma unroll
                for (int m = 0; m < 4; ++m)
#pragma unroll
                    for (int n = 0; n < 2; ++n) acc[a][b][m][n] = (f32x4){0.f, 0.f, 0.f, 0.f};
        cur = nxt; cB = nB; c00 = n00; c01 = n01; c10 = n10; c11 = n11; ++ui;
        if (wr == 1) PG8_BAR;
    }
    PG8_WAIT_V(0);
    PG8_BAR;
#undef PG8_ROWOFFS
#undef PG8_SA
#undef PG8_SB
#undef PG8_STAGE_A
#undef PG8_STAGE_B
#undef PG8_LDA
#undef PG8_LDB
#undef PG8_MMA
#undef PG8_WAIT_V
#undef PG8_WAIT_L
#undef PG8_BAR
#undef PG8_SCHED
}
}
using pg8::Unit;

struct SchedPlain {
    int nM, nN, nX, xpm0, xpn, G, c; unsigned rowbytes; const char* Bt; size_t btile;
    __device__ __forceinline__ bool next(int i, Unit& u) const {
        const int L = i * G + c, nwg = nM * nN;
        if (L < nwg) { pg8::swz_tile(L, nM, nN, u.pm, u.pn); }
        else if (L < nwg + nX) { u.pm = xpm0 + (L - nwg); u.pn = xpn; }
        else return false;
        u.e = 0; u.r0 = u.pm * 256; u.slot = i; return true;
    }
    __device__ __forceinline__ unsigned a_rowoff(const Unit& u, int r) const { return (unsigned)(u.r0 + r) * rowbytes; }
    __device__ __forceinline__ const char* b_ptr(const Unit& u) const { return Bt + (size_t)u.pn * btile; }
};
struct SchedOne {
    int pm, pn; unsigned rowbytes; const char* Bt; size_t btile;
    __device__ __forceinline__ bool next(int i, Unit& u) const { if (i != 0) return false; u.pm = pm; u.pn = pn; u.e = 0; u.r0 = pm * 256; u.slot = 0; return true; }
    __device__ __forceinline__ unsigned a_rowoff(const Unit& u, int r) const { return (unsigned)(u.r0 + r) * rowbytes; }
    __device__ __forceinline__ const char* b_ptr(const Unit& u) const { return Bt + (size_t)u.pn * btile; }
};
template <bool GATHER> struct SchedMoe {
    int ntile, G, c; unsigned rowbytes; const char* Bt; size_t btile, bexp;
    LAS const int* tile_e; LAS const int* tile_r0; LAS const int* idx;
    __device__ __forceinline__ bool next(int i, Unit& u) const {
        const int L = i * G + c; if (L >= 4 * ntile) return false;
        const int t = L >> 2; u.pn = L & 3; u.pm = t; u.e = __builtin_amdgcn_readfirstlane(tile_e[t]); u.r0 = __builtin_amdgcn_readfirstlane(tile_r0[t]); u.slot = i; return true;
    }
    __device__ __forceinline__ unsigned a_rowoff(const Unit& u, int r) const {
        if (GATHER) return (unsigned)idx[u.slot * 256 + r];
        else return (unsigned)(u.r0 + r) * rowbytes;
    }
    __device__ __forceinline__ const char* b_ptr(const Unit& u) const { return Bt + (size_t)u.e * bexp + (size_t)u.pn * btile; }
};

struct EpiProj {
    static constexpr bool PERM = false;
    bf16_t* O; LAS const float* rope;
    __device__ __forceinline__ void operator()(const f32x4 (&acc)[2][2][4][2], const Unit& u, int wr, int wc, int fr, int fq) const {
        const int row0 = u.pm * 256 + wr * 64 + fr, col0 = u.pn * 256 + wc * 32 + 8 * (fq >> 1) + 16 * (fq & 1);
        const bool lat = (u.pm * 256) < NLAT;
        const float qs = (u.pn < 2) ? QSCALE : 1.0f;
        const bool anyrot = lat && u.pn <= 2;
#pragma unroll
        for (int ai = 0; ai < 2; ++ai)
#pragma unroll
            for (int m = 0; m < 4; ++m) {
                const int row = row0 + ai * 128 + m * 16;
                bf16_t* rowp = O + (size_t)row * INW + col0;
                const int t = row & (SEQ - 1);
                const int pos = (wc & 1) ? (t & 63) : (t >> 6);
                f32x4 cs = {qs, qs, qs, qs}, sn = {0.f, 0.f, 0.f, 0.f};
                if (anyrot) { cs = *(LAS const f32x4*)(rope + pos * 16 + 4 * fq) * qs; sn = *(LAS const f32x4*)(rope + 1024 + pos * 16 + 4 * fq) * qs; }
#pragma unroll
                for (int bj = 0; bj < 2; ++bj) {
                    const f32x4 a = acc[ai][bj][m][0], b = acc[ai][bj][m][1];
                    f32x4 o0, o1;
                    if (anyrot && ((u.pn < 2) || (bj == 0))) { o0 = a * cs - b * sn; o1 = b * cs + a * sn; }
                    else { o0 = a * qs; o1 = b * qs; }
                    const auto r0_ = __builtin_amdgcn_permlane16_swap(pk2(o0[0], o0[1]), pk2(o1[0], o1[1]), false, false);
                    const auto r1_ = __builtin_amdgcn_permlane16_swap(pk2(o0[2], o0[3]), pk2(o1[2], o1[3]), false, false);
                    u32x4 w; w.x = r0_[0]; w.y = r1_[0]; w.z = r0_[1]; w.w = r1_[1];
                    *(u32x4*)(rowp + bj * 128) = w;
                }
            }
    }
};
struct EpiOut {
    static constexpr bool PERM = true;
    bf16_t* xb; const float* mod_l; float* pstat;
    __device__ __forceinline__ void operator()(const f32x4 (&acc)[2][2][4][2], const Unit& u, int wr, int wc, int fr, int fq) const {
        const int row0 = u.pm * 256 + wr * 64 + fr, col0 = u.pn * 256 + wc * 32 + 8 * fq;
        const int tr0 = u.pm * 256;
        const int mr = (tr0 < NLAT) ? (tr0 / SEQ) : 8;
        const float* gate = mod_l + mr * 6144 + 2 * D;
        f32x4 gv[2][2];
#pragma unroll
        for (int bj = 0; bj < 2; ++bj)
#pragma unroll
            for (int n = 0; n < 2; ++n) gv[bj][n] = *(const f32x4*)(gate + col0 + bj * 128 + n * 4);
#pragma unroll
        for (int ai = 0; ai < 2; ++ai) {
            u32x4 xi[4][2];
#pragma unroll
            for (int m = 0; m < 4; ++m) { const bf16_t* sp = xb + (size_t)(row0 + ai * 128 + m * 16) * D + col0;
#pragma unroll
                for (int bj = 0; bj < 2; ++bj) xi[m][bj] = *(const u32x4*)(sp + bj * 128); }
#pragma unroll
            for (int m = 0; m < 4; ++m) {
                const int row = row0 + ai * 128 + m * 16;
                bf16_t* dp = xb + (size_t)row * D + col0;
#pragma unroll
                for (int bj = 0; bj < 2; ++bj) {
                    const u32x4 xw = xi[m][bj];
                    const f32x4 y0 = ALPHA * (f32x4){bflo(xw.x), bfhi(xw.x), bflo(xw.y), bfhi(xw.y)} + gv[bj][0] * acc[ai][bj][m][0];
                    const f32x4 y1 = ALPHA * (f32x4){bflo(xw.z), bfhi(xw.z), bflo(xw.w), bfhi(xw.w)} + gv[bj][1] * acc[ai][bj][m][1];
                    u32x4 w; w.x = pk2(y0[0], y0[1]); w.y = pk2(y0[2], y0[3]); w.z = pk2(y1[0], y1[1]); w.w = pk2(y1[2], y1[3]);
                    *(u32x4*)(dp + bj * 128) = w;
                    float s = ((y0[0] + y0[1]) + (y0[2] + y0[3])) + ((y1[0] + y1[1]) + (y1[2] + y1[3]));
                    float q = ((y0[0] * y0[0] + y0[1] * y0[1]) + (y0[2] * y0[2] + y0[3] * y0[3])) + ((y1[0] * y1[0] + y1[1] * y1[1]) + (y1[2] * y1[2] + y1[3] * y1[3]));
                    const auto h_ = __builtin_amdgcn_permlane32_swap(__float_as_uint(s), __float_as_uint(q), false, false);
                    const float t_ = __uint_as_float(h_[0]) + __uint_as_float(h_[1]);
                    const auto g_ = __builtin_amdgcn_permlane16_swap(__float_as_uint(t_), __float_as_uint(t_), false, false);
                    const float tot_ = __uint_as_float(g_[0]) + __uint_as_float(g_[1]);
                    if ((fq & 1) == 0) pstat[((size_t)row * 32 + u.pn * 8 + bj * 4 + wc) * 2 + (fq >> 1)] = tot_;
                }
            }
        }
    }
};
struct EpiH {
    static constexpr bool PERM = true;
    unsigned char* H;
    __device__ __forceinline__ void operator()(const f32x4 (&acc)[2][2][4][2], const Unit& u, int wr, int wc, int fr, int fq) const {
        const int row0 = u.r0 + wr * 64 + fr, col0 = u.pn * 128 + wc * 32 + 8 * fq;
        constexpr float IS = 1.0f / W8_SCALE, OS = H8_SCALE / W8_SCALE;
#pragma unroll
        for (int ai = 0; ai < 2; ++ai)
#pragma unroll
            for (int m = 0; m < 4; ++m) {
                unsigned char* rowp = H + (size_t)(row0 + ai * 128 + m * 16) * DE + col0;
                u32x2 w;
                { const f32x4 a = acc[ai][0][m][0] * IS, b = acc[ai][1][m][0] * OS; w.x = pk4_fp8(silu_f(a[0]) * b[0], silu_f(a[1]) * b[1], silu_f(a[2]) * b[2], silu_f(a[3]) * b[3]); }
                { const f32x4 a = acc[ai][0][m][1] * IS, b = acc[ai][1][m][1] * OS; w.y = pk4_fp8(silu_f(a[0]) * b[0], silu_f(a[1]) * b[1], silu_f(a[2]) * b[2], silu_f(a[3]) * b[3]); }
                *(u32x2*)rowp = w;
            }
    }
};
struct EpiY {
    static constexpr bool PERM = true;
    unsigned char* Y;
    __device__ __forceinline__ void operator()(const f32x4 (&acc)[2][2][4][2], const Unit& u, int wr, int wc, int fr, int fq) const {
        const int row0 = u.r0 + wr * 64 + fr, col0 = u.pn * 256 + wc * 32 + 8 * fq;
        constexpr float OS = Y8_SCALE / (H8_SCALE * W8_SCALE);
#pragma unroll
        for (int ai = 0; ai < 2; ++ai)
#pragma unroll
            for (int m = 0; m < 4; ++m) {
                unsigned char* rowp = Y + (size_t)(row0 + ai * 128 + m * 16) * D + col0;
#pragma unroll
                for (int bj = 0; bj < 2; ++bj) { const f32x4 a = acc[ai][bj][m][0] * OS, b = acc[ai][bj][m][1] * OS;
                    u32x2 w; w.x = pk4_fp8(a[0], a[1], a[2], a[3]); w.y = pk4_fp8(b[0], b[1], b[2], b[3]); *(u32x2*)(rowp + bj * 128) = w; }
            }
    }
};

struct Args { const float* in[23]; float* out; unsigned char* ws; int ph_lo, ph_hi; };
typedef __attribute__((address_space(4))) const Args CArgs;
enum { I_X = 0, I_C, I_CTX, I_CCTX, I_WADA, I_BADA, I_WIN, I_CONVW, I_SINK, I_GMWS, I_GMBS, I_WOUT, I_LN1G, I_LN1B, I_WRG, I_BRG, I_WRE, I_BRE, I_W1, I_W3, I_W2, I_LN2G, I_LN2B };
constexpr int NPH = 16;

__device__ __forceinline__ void transpose_item(const float* W, int ldw, int k0, int n0, bf16_t* dst, int ldt, LAS float* scr, int lane) {
    float tv[32];
#pragma unroll
    for (int i = 0; i < 32; ++i) tv[i] = W[(size_t)(k0 + 2 * i + (lane >> 5)) * ldw + n0 + (lane & 31)];
#pragma unroll
    for (int i = 0; i < 32; ++i) scr[(2 * i + (lane >> 5)) * 33 + (lane & 31)] = tv[i];
    LDS_WAIT(); asm volatile("" ::: "memory");
    const int c = lane & 7;
#pragma unroll
    for (int j = 0; j < 4; ++j) { const int n = (lane >> 3) + 8 * j; const LAS float* s = scr + (8 * c) * 33 + n;
        u32x4 o; o.x = pk2(s[0 * 33], s[1 * 33]); o.y = pk2(s[2 * 33], s[3 * 33]); o.z = pk2(s[4 * 33], s[5 * 33]); o.w = pk2(s[6 * 33], s[7 * 33]);
        *(u32x4*)(dst + (size_t)n * ldt + k0 + 8 * c) = o; }
    LDS_WAIT(); asm volatile("" ::: "memory");
}
__device__ __forceinline__ void transpose_item8(const float* W, int ldw, int k0, int n0, unsigned char* dst8, int ldt, float scale, LAS float* scr, int lane) {
    float tv[32];
#pragma unroll
    for (int i = 0; i < 32; ++i) tv[i] = W[(size_t)(k0 + 2 * i + (lane >> 5)) * ldw + n0 + (lane & 31)];
#pragma unroll
    for (int i = 0; i < 32; ++i) scr[(2 * i + (lane >> 5)) * 33 + (lane & 31)] = tv[i];
    LDS_WAIT(); asm volatile("" ::: "memory");
    const int c = lane & 7;
#pragma unroll
    for (int j = 0; j < 4; ++j) { const int n = (lane >> 3) + 8 * j; const LAS float* sp = scr + (8 * c) * 33 + n;
        u32x2 o; o.x = pk4_fp8(sp[0 * 33] * scale, sp[1 * 33] * scale, sp[2 * 33] * scale, sp[3 * 33] * scale); o.y = pk4_fp8(sp[4 * 33] * scale, sp[5 * 33] * scale, sp[6 * 33] * scale, sp[7 * 33] * scale);
        *(u32x2*)(dst8 + (size_t)n * ldt + k0 + 8 * c) = o; }
    LDS_WAIT(); asm volatile("" ::: "memory");
}
constexpr int CV_I13 = NE * 16 * 16, CV_I2 = NE * 8 * 32, CV_ITEMS = 2 * CV_I13 + CV_I2, CV_UNITS = CV_ITEMS / 64;
__device__ __forceinline__ void convert_item(const float* w1, const float* w3, const float* w2, bf16_t* W13T, bf16_t* W2T, int l, int it, LAS float* scr, int lane) {
    if (it < 2 * CV_I13) {
        const int which = it / CV_I13, r = it % CV_I13, e = r / 256, q = r % 256, kb = q / 16, nb = q % 16, n0 = nb * 32;
        const float* W = (which ? w3 : w1) + ((size_t)l * NE + e) * (size_t)D * DE;
        unsigned char* dst = (unsigned char*)W13T + ((size_t)e * 1024 + (n0 >> 7) * 256 + which * 128 + (n0 & 127)) * D;
        transpose_item8(W, DE, kb * 64, n0, dst, D, W8_SCALE, scr, lane);
    } else {
        const int r = it - 2 * CV_I13, e = r / 256, q = r % 256, kb = q / 32, nb = q % 32, n0 = nb * 32;
        const float* W = w2 + ((size_t)l * NE + e) * (size_t)DE * D;
        unsigned char* dst = (unsigned char*)W2T + ((size_t)e * 1024 + n0) * DE;
        transpose_item8(W, D, kb * 64, n0, dst, DE, W8_SCALE, scr, lane);
    }
}

struct CvItem { const float* W; unsigned char* dst; int ldw, ldt, k0, n0; };
__device__ __forceinline__ CvItem cv_decode(const float* w1, const float* w3, const float* w2, bf16_t* W13T, bf16_t* W2T, int l, int it) {
    CvItem c;
    if (it < 2 * CV_I13) {
        const int which = it / CV_I13, r = it % CV_I13, e = r / 256, q = r % 256, kb = q / 16, nb = q % 16, n0 = nb * 32;
        c.W = (which ? w3 : w1) + ((size_t)l * NE + e) * (size_t)D * DE; c.ldw = DE; c.k0 = kb * 64; c.n0 = n0;
        c.dst = (unsigned char*)W13T + ((size_t)e * 1024 + (n0 >> 7) * 256 + which * 128 + (n0 & 127)) * D; c.ldt = D;
    } else {
        const int r = it - 2 * CV_I13, e = r / 256, q = r % 256, kb = q / 32, nb = q % 32, n0 = nb * 32;
        c.W = w2 + ((size_t)l * NE + e) * (size_t)DE * D; c.ldw = D; c.k0 = kb * 64; c.n0 = n0;
        c.dst = (unsigned char*)W2T + ((size_t)e * 1024 + n0) * DE; c.ldt = DE;
    }
    return c;
}
__device__ __forceinline__ void cv_load(const CvItem& c, int lane, f32x4 (&t)[8]) {
#pragma unroll
    for (int i = 0; i < 8; ++i) t[i] = __builtin_nontemporal_load((const f32x4*)(c.W + (size_t)(c.k0 + 8 * i + (lane >> 3)) * c.ldw + c.n0 + 4 * (lane & 7)));
}
__device__ __forceinline__ void cv_store(const CvItem& c, const f32x4 (&t)[8], LAS float* scr, int lane) {
#pragma unroll
    for (int i = 0; i < 8; ++i) { LAS float* p = scr + (8 * i + (lane >> 3)) * 33 + 4 * (lane & 7); p[0] = t[i][0]; p[1] = t[i][1]; p[2] = t[i][2]; p[3] = t[i][3]; }
    LDS_WAIT(); asm volatile("" ::: "memory");
    const int kc = lane & 7;
#pragma unroll
    for (int j = 0; j < 4; ++j) { const int n = (lane >> 3) + 8 * j; const LAS float* sp = scr + (8 * kc) * 33 + n;
        u32x2 o; o.x = pk4_fp8(sp[0 * 33] * W8_SCALE, sp[1 * 33] * W8_SCALE, sp[2 * 33] * W8_SCALE, sp[3 * 33] * W8_SCALE); o.y = pk4_fp8(sp[4 * 33] * W8_SCALE, sp[5 * 33] * W8_SCALE, sp[6 * 33] * W8_SCALE, sp[7 * 33] * W8_SCALE);
        *(u32x2*)(c.dst + (size_t)n * c.ldt + c.k0 + 8 * kc) = o; }
    LDS_WAIT(); asm volatile("" ::: "memory");
}
__device__ __forceinline__ void convert_unit(const float* w1, const float* w3, const float* w2, bf16_t* W13T, bf16_t* W2T, int l, int cvu, int wave, LAS float* scr, int lane) {
    const int it0 = cvu * 64 + wave * 8;
    CvItem cur = cv_decode(w1, w3, w2, W13T, W2T, l, it0);
    f32x4 ta[8], tb[8];
    cv_load(cur, lane, ta);
#pragma unroll 1
    for (int j = 0; j < 8; j += 2) {
        const CvItem n1 = cv_decode(w1, w3, w2, W13T, W2T, l, it0 + j + 1);
        cv_load(n1, lane, tb);
        cv_store(cur, ta, scr, lane);
        CvItem n2 = n1;
        if (j + 2 < 8) { n2 = cv_decode(w1, w3, w2, W13T, W2T, l, it0 + j + 2); cv_load(n2, lane, ta); }
        cv_store(n1, tb, scr, lane);
        cur = n2;
    }
}

__global__ void __launch_bounds__(512, 2) fwd_kernel(Args args) {
    extern __shared__ __attribute__((aligned(16))) unsigned char lds_raw[];
    LAS unsigned char* lds = (LAS unsigned char*)lds_raw;
    volatile LAS unsigned* MISC = (volatile LAS unsigned*)(lds + MISC_OFF);
    const int tid = threadIdx.x, lane = tid & 63, wave = __builtin_amdgcn_readfirstlane(tid >> 6);
    const int G = gridDim.x, bx = blockIdx.x;
    const int gw = bx * 8 + wave, NGW = G * 8;
#define KARGS() ({ CArgs* _kp = (CArgs*)__builtin_amdgcn_kernarg_segment_ptr(); asm volatile("" : "+s"(_kp)); _kp; })
#define PHASE_PTRS() CArgs* kp = KARGS(); unsigned char* const ws = kp->ws; int tid = threadIdx.x; asm volatile("" : "+v"(tid)); const int lane = tid & 63
#define ctl ((gu32*)(ws + WS_CTL))
#define modall ((float*)(ws + WS_MOD))
#define rope ((float*)(ws + WS_ROPE))
#define gmw ((bf16_t*)(ws + WS_GMW))
#define tokinfo ((int*)(ws + WS_TOKINFO))
#define gates ((float*)(ws + WS_GATES))
#define elist ((int*)(ws + WS_LIST))
#define WinT ((bf16_t*)(ws + WS_WIN))
#define WoutT ((bf16_t*)(ws + WS_WOUT))
#define W13T ((bf16_t*)(ws + WS_W13))
#define W2T ((bf16_t*)(ws + WS_W2))
#define hx ((bf16_t*)(ws + WS_HX))
#define xbuf ((bf16_t*)(ws + WS_XBUF))
#define proj ((bf16_t*)(ws + WS_PROJ))
#define mix ((bf16_t*)(ws + WS_MIX))
#define Hb ((bf16_t*)(ws + WS_H))
#define Yb ((bf16_t*)(ws + WS_Y))
#define mod_l (modall + (size_t)l * 9 * 6144)
#define cnt_l (ctl + CW_CNT + l * 64)
    CArgs* kp0 = KARGS();
    for (int u = tid; u < 64; u += 512) ((LAS unsigned*)(lds + MISC_OFF))[u] = 0u;
    __syncthreads();
    XcdBarrier bar; bar.bar = (unsigned*)(kp0->ws + WS_CTL) + CW_BAR; bar.x = 0; bar.st = nullptr;
    if (MK_N_LAUNCHES == 1) bar = xcd_barrier_post((unsigned*)(kp0->ws + WS_CTL) + CW_BAR, MISC + 8);
    const int lo = kp0->ph_lo, hi = kp0->ph_hi;
#ifndef PH_MASK
#define PH_MASK 0xFFFFFFFFu
#endif
#define IN(k) (((PH_MASK >> ((k) < 2 ? (k) : 2 + ((k) - 2) % 7)) & 1u) && lo <= (k) && (k) < hi)
#if defined(PROBE_A)
    unsigned long long pr_prev = __builtin_amdgcn_s_memrealtime(), pr_a = 0, pr_b = 0;
#define PROBE_MARK(k) do { const unsigned long long now_ = __builtin_amdgcn_s_memrealtime(); if ((PROBE_A >> (k)) & 1u) pr_a += now_ - pr_prev; if ((PROBE_B >> (k)) & 1u) pr_b += now_ - pr_prev; pr_prev = now_; } while (0)
#else
#define PROBE_MARK(k) do { } while (0)
#endif
#define GRID_BAR(k) do { if (IN(k) && IN((k) + 1)) xcd_barrier(bar); PROBE_MARK(k); } while (0)

    if (IN(0)) {
            PHASE_PTRS();
        LAS float* cs = (LAS float*)(lds + 73728);
        LAS float* red = (LAS float*)(lds + 73728 + 36864);
        {
            f32x4 t_[5];
#pragma unroll
            for (int i = 0; i < 5; ++i) { const int idx = tid + 512 * i; if (idx < 9 * D / 4) { const int r = idx >> 8, k4 = (idx & 255) * 4; t_[i] = (r < 8) ? *(const f32x4*)(kp->in[I_C] + r * D + k4) : *(const f32x4*)(kp->in[I_CCTX] + k4); } }
#pragma unroll
            for (int i = 0; i < 5; ++i) { const int idx = tid + 512 * i; if (idx < 9 * D / 4) { *(LAS f32x4*)(cs + 4 * idx) = (f32x4){silu_f(t_[i][0]), silu_f(t_[i][1]), silu_f(t_[i][2]), silu_f(t_[i][3])}; } }
        }
        __syncthreads();
        for (int item = bx; item < 2 * 96; item += G) {
            const int l = item / 96, n0 = (item % 96) * 64;
            const int kq = lane >> 4, cg = lane & 15;
            const float* wp = kp->in[I_WADA] + ((size_t)l * D + wave * 128 + kq) * 6144 + n0 + 4 * cg;
            f32x4 a[9];
#pragma unroll
            for (int r = 0; r < 9; ++r) a[r] = (f32x4){0.f, 0.f, 0.f, 0.f};
#pragma unroll 4
            for (int i = 0; i < 32; ++i) {
                const f32x4 w = __builtin_nontemporal_load((const f32x4*)(wp + (size_t)(4 * i) * 6144));
                const int k = wave * 128 + 4 * i + kq;
#pragma unroll
                for (int r = 0; r < 9; ++r) a[r] += cs[r * D + k] * w;
            }
#pragma unroll
            for (int r = 0; r < 9; ++r)
#pragma unroll
                for (int j = 0; j < 4; ++j) { float v = a[r][j]; v += __shfl_xor(v, 16); v += __shfl_xor(v, 32); a[r][j] = v; }
            if (kq == 0) {
#pragma unroll
                for (int r = 0; r < 9; ++r)
#pragma unroll
                    for (int j = 0; j < 4; ++j) red[(wave * 9 + r) * 64 + 4 * cg + j] = a[r][j];
            }
            __syncthreads();
            for (int i = tid; i < 9 * 64; i += 512) {
                const int r = i >> 6, cidx = i & 63; float s = 0.f;
#pragma unroll
                for (int w = 0; w < 8; ++w) s += red[(w * 9 + r) * 64 + cidx];
                modall[((size_t)l * 9 + r) * 6144 + n0 + cidx] = s + kp->in[I_BADA][l * 6144 + n0 + cidx];
            }
            __syncthreads();
        }
        if (bx == G - 1) {
            for (int i = tid; i < 1024; i += 512) { const int pos = i >> 4, f = i & 15; const float fr_ = powf(10000.0f, -(float)f / 16.0f); const float ang = (float)pos * fr_; rope[i] = cosf(ang); rope[1024 + i] = sinf(ang); }
        }
        for (int i = bx * 512 + tid; i < 2 * D * 36; i += G * 512) {
            const int l = i / (D * 36), r = i % (D * 36), k = r / 36, o_ = r % 36;
            const float w = (o_ < 4) ? kp->in[I_WRG][((size_t)l * D + k) * 4 + o_] : kp->in[I_WRE][((size_t)l * D + k) * 32 + (o_ - 4)];
            const unsigned hi_ = f2bf(w); const unsigned lo_ = f2bf(w - bf2f((unsigned short)hi_));
            bf16_t* img = (bf16_t*)(ws + WS_WRIMG + (size_t)l * WRIMG_BYTES);
            img[(o_ * WR_RS) / 2 + k] = (bf16_t)hi_; img[(WR_LO + o_ * WR_RS) / 2 + k] = (bf16_t)lo_;
        }
        for (int i = bx * 512 + tid; i < 2 * 4 * 128 * 128; i += G * 512) gmw[i] = (bf16_t)f2bf(kp->in[I_GMWS][i]);
        LAS float* scr = (LAS float*)(lds + wave * 9216);
        {
            constexpr int IW = 16 * 64, IO = 16 * 32;
            for (int it = gw; it < 2 * IW + 2 * IO; it += NGW) {
                if (it < 2 * IW) { const int l = it / IW, q = it % IW, kb = q / 64, nb = q % 64;
                    transpose_item(kp->in[I_WIN] + (size_t)l * D * INW, INW, kb * 64, nb * 32, WinT + ((size_t)l * INW + nb * 32) * D, D, scr, lane); }
                else { const int r = it - 2 * IW, l = r / IO, q = r % IO, kb = q / 32, nb = q % 32;
                    transpose_item(kp->in[I_WOUT] + (size_t)l * D * D, D, kb * 64, nb * 32, WoutT + ((size_t)l * D + nb * 32) * D, D, scr, lane); }
            }
        }
    }
    GRID_BAR(0);

    if (IN(1)) {
            PHASE_PTRS();
        for (int i = bx * 512 + tid; i < 2 * 9 * D; i += G * 512) {
            const int l = i / (9 * D), r = (i / D) % 9, c = i % D;
            const float* md = modall + ((size_t)l * 9 + r) * 6144;
            const float g = kp->in[I_LN1G][l * D + c], b = kp->in[I_LN1B][l * D + c], sc = md[4 * D + c], sh = md[3 * D + c];
            float* gc = (float*)(ws + WS_GC) + ((size_t)(l * 9 + r) * 2) * D;
            gc[c] = g * (1.0f + sc); gc[D + c] = b * (1.0f + sc) + sh;
        }
        for (int r = gw; r < NROW; r += NGW) {
            const float* src = (r < NLAT) ? kp->in[I_X] + (size_t)r * D : kp->in[I_CTX] + (size_t)(r - NLAT) * D;
            const float* md = modall + (size_t)((r < NLAT) ? (r / SEQ) : 8) * 6144;
            u32x2* dst = (u32x2*)(hx + (size_t)r * D);
#pragma unroll
            for (int j = 0; j < 4; ++j) {
                const int c = 256 * j + 4 * lane;
                const f32x4 v = __builtin_nontemporal_load((const f32x4*)(src + c)), sh = *(const f32x4*)(md + c), sc = *(const f32x4*)(md + D + c);
                const f32x4 h = v * (1.0f + sc) + sh;
                u32x2 w; w.x = pk2(h[0], h[1]); w.y = pk2(h[2], h[3]); dst[64 * j + lane] = w;
                u32x2 wx; wx.x = pk2(v[0], v[1]); wx.y = pk2(v[2], v[3]); ((u32x2*)(xbuf + (size_t)r * D))[64 * j + lane] = wx;
            }
        }
    }
    GRID_BAR(1);

    for (int l = 0; l < DEPTH; ++l) {
        const int pb = 2 + 7 * l;
        const bool lastl = (l == DEPTH - 1);
        const int nrow_l = lastl ? NLAT : NROW;

        if (IN(pb + 0)) {
            PHASE_PTRS();
            SchedPlain S; S.nM = NLAT / 256; S.nN = 8; S.nX = 0; S.xpm0 = 0; S.xpn = 0; S.G = G; S.c = bx;
            S.rowbytes = D * 2; S.Bt = (const char*)(WinT + (size_t)l * INW * D); S.btile = (size_t)256 * D * 2;
            __builtin_amdgcn_global_load_lds((const unsigned*)(rope + 256 * wave + 4 * lane), (LAS unsigned*)(lds + L_ROPE + 1024 * wave), 16, 0, 0);
            asm volatile("s_waitcnt vmcnt(0)" ::: "memory");
            __syncthreads();
            EpiProj E{proj, (LAS const float*)(lds + L_ROPE)};
            pg8::gemm_phase<EpiProj, SchedPlain, false>(lds, (const char*)hx, D * 2, S, E);
        }
        GRID_BAR(pb + 0);

        if (IN(pb + 1)) {
            PHASE_PTRS();
            const int n_att = NB * 32 * 2 + (lastl ? 0 : NB * 2 * 2);
            const int n_loc = nrow_l / 128;
            gu32* cproj = ctl + CW_DEP + l * 16; gu32* cmix = ctl + CW_DEP + 32;
            const unsigned need_proj = lastl ? 1u : 8u;
#define DEP_PUBLISH(ctr_) do { asm volatile("s_waitcnt vmcnt(0)" ::: "memory"); __syncthreads(); \
                if (threadIdx.x == 0) { __builtin_amdgcn_fence(__ATOMIC_RELEASE, "agent"); asm volatile("s_waitcnt vmcnt(0)" ::: "memory"); __hip_atomic_fetch_add((ctr_), 1u, __ATOMIC_RELAXED, __HIP_MEMORY_SCOPE_AGENT); } } while (0)
#define DEP_ENSURE(bit_, ctr_, need_) do { const unsigned m_ = MISC[24]; if (!((m_ >> (bit_)) & 1u)) { \
                if (threadIdx.x == 0) { unsigned sp_ = 0; while (__hip_atomic_load((ctr_), __ATOMIC_RELAXED, __HIP_MEMORY_SCOPE_AGENT) < (need_)) { __builtin_amdgcn_s_sleep(4); \
                        if (++sp_ > (1u << 22)) { __hip_atomic_store(ctl + CW_TMO, 1u, __ATOMIC_RELAXED, __HIP_MEMORY_SCOPE_AGENT); break; } } \
                    __builtin_amdgcn_fence(__ATOMIC_ACQUIRE, "agent"); asm volatile("s_waitcnt vmcnt(0)" ::: "memory"); MISC[24] = m_ | (1u << (bit_)); } \
                __syncthreads(); } } while (0)
            const int n_gin = lastl ? NB : NB * 8, n_cmid = lastl ? 0 : (NB * 4 + NCTX / 128), n_gout = lastl ? 0 : NB * 4;
            const int q1 = n_gin, q2 = q1 + 384, q3 = q2 + n_cmid, q4 = q3 + 384, q5 = q4 + n_gout, q6 = q5 + 128, q8 = q6 + NLAT / 128;
            static_assert(CV_UNITS == 384, "queue layout assumes 384 conversion units");
            gu32* qctr = ctl + CW_Q + l * 64;
            if (tid == 0) { MISC[16] = __hip_atomic_fetch_add(qctr, 1u, __ATOMIC_RELAXED, __HIP_MEMORY_SCOPE_AGENT); MISC[24] = 0u; }
            __syncthreads();
            int qpar = 0;
            for (;;) {
                const int qi = (int)MISC[16 + qpar];
                if (qi >= q8) break;
                if (tid == 0) MISC[16 + (qpar ^ 1)] = __hip_atomic_fetch_add(qctr, 1u, __ATOMIC_RELAXED, __HIP_MEMORY_SCOPE_AGENT);
                qpar ^= 1;
                int utype, uidx;
                if (qi < q1) { utype = 3; uidx = qi; }
                else if (qi < q2) { const int r = qi - q1; utype = (r & 1) ? 0 : 1; uidx = r >> 1; }
                else if (qi < q3) { const int r = qi - q2; if (r < NB * 4) { utype = 1; uidx = NB * 64 + r; } else { utype = 2; uidx = NLAT / 128 + (r - NB * 4); } }
                else if (qi < q4) { const int r = qi - q3; utype = (r & 1) ? 0 : 1; uidx = 192 + (r >> 1); }
                else if (qi < q5) { utype = 4; uidx = qi - q4; }
                else if (qi < q6) { utype = 1; uidx = 384 + (qi - q5); }
                else { utype = 2; uidx = qi - q6; }
                if (utype == 3) {
                    const int cb = lastl ? uidx : (uidx >> 3), pn = lastl ? 2 : (uidx & 7);
                    SchedOne S1; S1.pm = NLAT / 256 + cb; S1.pn = pn; S1.rowbytes = D * 2; S1.Bt = (const char*)(WinT + (size_t)l * INW * D); S1.btile = (size_t)256 * D * 2;
                    EpiProj E1{proj, (LAS const float*)(lds + L_ROPE)};
                    pg8::gemm_phase<EpiProj, SchedOne, false>(lds, (const char*)hx, D * 2, S1, E1);
                    DEP_PUBLISH(cproj + cb);
                    __syncthreads();
                } else if (utype == 4) {
                    const int cb = uidx >> 2, pn = uidx & 3;
                    DEP_ENSURE(8 + cb, cmix + cb, 6u);
                    SchedOne S1; S1.pm = NLAT / 256 + cb; S1.pn = pn; S1.rowbytes = D * 2; S1.Bt = (const char*)(WoutT + (size_t)l * D * D); S1.btile = (size_t)256 * D * 2;
                    EpiOut E1{xbuf, mod_l, (float*)(ws + WS_PSTAT)};
                    pg8::gemm_phase<EpiOut, SchedOne, false>(lds, (const char*)mix, D * 2, S1, E1);
                    __syncthreads();
                } else if (utype == 0) {
                    int tidb_ = threadIdx.x; asm volatile("" : "+v"(tidb_)); const int tid = tidb_, lane = tid & 63;
                    LAS float* scr = (LAS float*)(lds + wave * 9216);
                    convert_unit(kp->in[I_W1], kp->in[I_W3], kp->in[I_W2], W13T, W2T, l, uidx, wave, scr, lane);
                    __syncthreads();
                } else if (utype == 1) {
                    int tidb_ = threadIdx.x; asm volatile("" : "+v"(tidb_)); const int tid = tidb_, lane = tid & 63;
                    int b, nb, g, qrow0; unsigned cmask;
                    if (uidx < NB * 64) { b = uidx >> 6; nb = (uidx >> 1) & 31; g = uidx & 1; qrow0 = b * SEQ + nb * 128; cmask = 0x1fu & ~(nb == 0 ? 1u : 0u) & ~(nb == 31 ? 4u : 0u); }
                    else { const int v = uidx - NB * 64; b = v >> 2; nb = 0; g = v & 1; qrow0 = NLAT + b * CTXL + ((v >> 1) & 1) * 128; cmask = 0x18u; }
                    if (uidx >= NB * 64) DEP_ENSURE(b, cproj + b, need_proj);
                    const int r32 = lane & 31, hi_ = lane >> 5;
                    const int hh = 4 * g + (wave & 3), qs = 64 * (wave >> 2);
                    const int blk = (lane >> 4) & 1, qq = (lane & 15) >> 2, pp = lane & 3;
                    u32x4 kreg[2], vreg[2];
#define ATT_LOAD(c_) do { const int krow0_ = ((c_) < 3) ? (b * SEQ + (nb - 1 + (c_)) * 128) : (NLAT + b * CTXL + ((c_) - 3) * 128); \
                        _Pragma("unroll") for (int i_ = 0; i_ < 2; ++i_) { const int p_ = tid + 512 * i_; const bf16_t* src_ = proj + (size_t)(krow0_ + (p_ >> 3)) * INW + 512 + 64 * g + (p_ & 7) * 8; \
                            kreg[i_] = *(const u32x4*)src_; vreg[i_] = *(const u32x4*)(src_ + 128); } } while (0)
#define ATT_STORE(buf_) do { _Pragma("unroll") for (int i_ = 0; i_ < 2; ++i_) { const int p_ = tid + 512 * i_; \
                            *(LAS u32x4*)(lds + (buf_) * 36864 + (p_ >> 3) * 144 + (p_ & 7) * 16) = kreg[i_]; *(LAS u32x4*)(lds + (buf_) * 36864 + 18432 + (p_ >> 3) * 144 + (p_ & 7) * 16) = vreg[i_]; } } while (0)
                    int c = __builtin_ctz(cmask); cmask &= cmask - 1;
                    ATT_LOAD(c);
                    bf16x8 qf[2][4];
                    {
                        LAS unsigned char* qst = lds + 73728 + wave * 9216;
                        u32x4 qreg[8];
#pragma unroll
                        for (int it = 0; it < 8; ++it) qreg[it] = *(const u32x4*)(proj + (size_t)(qrow0 + qs + it * 8 + (lane >> 3)) * INW + hh * 64 + (lane & 7) * 8);
#pragma unroll
                        for (int it = 0; it < 8; ++it) *(LAS u32x4*)(qst + (it * 8 + (lane >> 3)) * 144 + (lane & 7) * 16) = qreg[it];
                        LDS_WAIT();
#pragma unroll
                        for (int qt = 0; qt < 2; ++qt)
#pragma unroll
                            for (int d0 = 0; d0 < 4; ++d0) qf[qt][d0] = *(const LAS bf16x8*)(qst + (32 * qt + r32) * 144 + (16 * d0 + 8 * hi_) * 2);
                    }
                    float mref[2], lrun[2]; f32x16 o[2][2];
                    const float sink2 = kp->in[I_SINK][l * 8 + hh] * LOG2E;
#pragma unroll
                    for (int qt = 0; qt < 2; ++qt) { mref[qt] = sink2; lrun[qt] = hi_ ? 0.f : 1.f;
#pragma unroll
                        for (int db = 0; db < 2; ++db)
#pragma unroll
                            for (int r = 0; r < 16; ++r) o[qt][db][r] = 0.f; }
                    ATT_STORE(0);
                    __syncthreads();
                    int buf = 0;
                    for (;;) {
                        const int cn = cmask ? __builtin_ctz(cmask) : -1;
                        if (cn >= 3) DEP_ENSURE(b, cproj + b, need_proj);
                        if (cn >= 0) ATT_LOAD(cn);
                        const int mtype = (c == 0) ? 1 : ((c == 2) ? 2 : 0);
                        const LAS unsigned char* Kl = lds + buf * 36864; const LAS unsigned char* Vl = Kl + 18432;
#pragma unroll 1
                        for (int kvt = 0; kvt < 4; ++kvt) {
                            if (mtype == 1 && 32 * kvt + 31 < qs) continue;
                            if (mtype == 2 && 32 * kvt > qs + 63) continue;
                            bf16x8 kf[4];
#pragma unroll
                            for (int d0 = 0; d0 < 4; ++d0) kf[d0] = *(const LAS bf16x8*)(Kl + (32 * kvt + r32) * 144 + (16 * d0 + 8 * hi_) * 2);
                            bf16x8 vf[2][2];
#pragma unroll
                            for (int db = 0; db < 2; ++db)
#pragma unroll
                                for (int ks = 0; ks < 2; ++ks) {
                                    const LAS unsigned char* p0 = Vl + (32 * kvt + 16 * ks + 4 * hi_ + qq) * 144 + (32 * db + 16 * blk + 4 * pp) * 2;
                                    const s16x4 t0 = __builtin_bit_cast(s16x4, __builtin_amdgcn_ds_read_tr16_b64_v4i16((LAS s16x4*)p0));
                                    const s16x4 t1 = __builtin_bit_cast(s16x4, __builtin_amdgcn_ds_read_tr16_b64_v4i16((LAS s16x4*)(p0 + 8 * 144)));
                                    vf[db][ks] = (bf16x8){t0[0], t0[1], t0[2], t0[3], t1[0], t1[1], t1[2], t1[3]};
                                }
#pragma unroll
                            for (int qt = 0; qt < 2; ++qt) {
                                const int i0 = qs + 32 * qt;
                                if (mtype == 1 && 32 * kvt + 31 < i0) continue;
                                if (mtype == 2 && 32 * kvt > i0 + 31) continue;
                                f32x16 sv;
#pragma unroll
                                for (int r = 0; r < 16; ++r) sv[r] = 0.f;
#pragma unroll
                                for (int d0 = 0; d0 < 4; ++d0) sv = __builtin_amdgcn_mfma_f32_32x32x16_bf16(kf[d0], qf[qt][d0], sv, 0, 0, 0);
                                if (mtype != 0 && 32 * kvt == i0) {
                                    const int thr = r32 - 4 * hi_;
                                    if (mtype == 1) {
#pragma unroll
                                        for (int r = 0; r < 16; ++r) sv[r] = (((r & 3) + 8 * (r >> 2)) < thr) ? -INFINITY : sv[r];
                                    } else {
#pragma unroll
                                        for (int r = 0; r < 16; ++r) sv[r] = (((r & 3) + 8 * (r >> 2)) > thr) ? -INFINITY : sv[r];
                                    }
                                }
#pragma unroll
                                for (int r = 0; r < 16; ++r) sv[r] -= mref[qt];
                                float tmax = fmaxf(fmaxf(sv[0], sv[1]), fmaxf(sv[2], sv[3]));
#pragma unroll
                                for (int r = 4; r < 16; r += 4) tmax = fmaxf(tmax, fmaxf(fmaxf(sv[r], sv[r + 1]), fmaxf(sv[r + 2], sv[r + 3])));
                                if (__any(tmax > 8.0f)) {
                                    tmax = fmaxf(tmax, __shfl_xor(tmax, 32));
                                    const float dl = fmaxf(tmax, 0.f);
                                    mref[qt] += dl;
                                    const float f = __builtin_amdgcn_exp2f(-dl);
                                    lrun[qt] *= f;
#pragma unroll
                                    for (int r = 0; r < 16; ++r) sv[r] -= dl;
#pragma unroll
                                    for (int db = 0; db < 2; ++db)
#pragma unroll
                                        for (int r = 0; r < 16; ++r) o[qt][db][r] *= f;
                                }
                                float psum = 0.f;
#pragma unroll
                                for (int r = 0; r < 16; ++r) { sv[r] = __builtin_amdgcn_exp2f(sv[r]); psum += sv[r]; }
                                lrun[qt] += psum;
                                bf16x8 pf[2];
#pragma unroll
                                for (int ks = 0; ks < 2; ++ks) { u32x4 w; w.x = pk2(sv[8 * ks + 0], sv[8 * ks + 1]); w.y = pk2(sv[8 * ks + 2], sv[8 * ks + 3]); w.z = pk2(sv[8 * ks + 4], sv[8 * ks + 5]); w.w = pk2(sv[8 * ks + 6], sv[8 * ks + 7]); pf[ks] = __builtin_bit_cast(bf16x8, w); }
#pragma unroll
                                for (int db = 0; db < 2; ++db)
#pragma unroll
                                    for (int ks = 0; ks < 2; ++ks) o[qt][db] = __builtin_amdgcn_mfma_f32_32x32x16_bf16(vf[db][ks], pf[ks], o[qt][db], 0, 0, 0);
                            }
                        }
                        if (cn < 0) break;
                        ATT_STORE(buf ^ 1);
                        __syncthreads();
                        buf ^= 1; c = cn; cmask &= cmask - 1;
                    }
#undef ATT_LOAD
#undef ATT_STORE
                    LAS unsigned char* ost = lds + 73728 + wave * 4608;
#pragma unroll
                    for (int qt = 0; qt < 2; ++qt) {
                        float lt = lrun[qt]; lt += __shfl_xor(lt, 32);
                        const float inv = 1.0f / lt;
#pragma unroll
                        for (int db = 0; db < 2; ++db)
#pragma unroll
                            for (int rg = 0; rg < 4; ++rg) { u32x2 w; w.x = pk2(o[qt][db][4 * rg + 0] * inv, o[qt][db][4 * rg + 1] * inv); w.y = pk2(o[qt][db][4 * rg + 2] * inv, o[qt][db][4 * rg + 3] * inv);
                                *(LAS u32x2*)(ost + r32 * 144 + (32 * db + 8 * rg + 4 * hi_) * 2) = w; }
                        LDS_WAIT();
                        bf16_t* obase = mix + (size_t)(qrow0 + qs + 32 * qt) * D + hh * 64;
#pragma unroll
                        for (int it = 0; it < 4; ++it) { const int row = it * 8 + (lane >> 3), ch = lane & 7;
                            const u32x4 v = *(const LAS u32x4*)(ost + row * 144 + ch * 16); *(u32x4*)(obase + (size_t)row * D + ch * 8) = v; }
                        LDS_WAIT();
                    }
                    if (uidx >= NB * 64) DEP_PUBLISH(cmix + b);
                    __syncthreads();
                } else {
                    int tidb_ = threadIdx.x; asm volatile("" : "+v"(tidb_)); const int tid = tidb_, lane = tid & 63;
                    const int ch = uidx, row0 = ch * 128;
                    const int cb_loc = (ch - NLAT / 128) >> 1;
                    if (ch >= NLAT / 128) DEP_ENSURE(cb_loc, cproj + cb_loc, need_proj);
                    const int seqlen = (row0 < NLAT) ? SEQ : CTXL;
                    const int sbase = (row0 < NLAT) ? (row0 / SEQ) * SEQ : NLAT + ((row0 - NLAT) / CTXL) * CTXL;
                    {
                        const int c8 = (tid & 31) * 8, tg = tid >> 5;
                        const float* cw = kp->in[I_CONVW] + (size_t)l * 3 * 256;
                        const int t0 = row0 + tg * 8;
                        u32x4 ccv[10], cxv[10], cbv[8];
#pragma unroll
                        for (int i = 0; i < 10; ++i) {
                            int row = t0 - 1 + i; const bool ok = (row >= sbase) && (row < sbase + seqlen); row = ok ? row : t0;
                            ccv[i] = *(const u32x4*)(proj + (size_t)row * INW + 1024 + c8); cxv[i] = *(const u32x4*)(proj + (size_t)row * INW + 1280 + c8);
                            if (!ok) { ccv[i] = (u32x4){0u, 0u, 0u, 0u}; }
                        }
#pragma unroll
                        for (int i = 0; i < 8; ++i) cbv[i] = *(const u32x4*)(proj + (size_t)(t0 + i) * INW + 768 + c8);
                        float w0[8], w1[8], w2[8];
#pragma unroll
                        for (int j = 0; j < 8; ++j) { w0[j] = cw[c8 + j]; w1[j] = cw[256 + c8 + j]; w2[j] = cw[512 + c8 + j]; }
#define ZROW(Z_, i) do { const u32x4 cc = ccv[i], cx = cxv[i]; Z_[0] = bflo(cc.x) * bflo(cx.x); Z_[1] = bfhi(cc.x) * bfhi(cx.x); Z_[2] = bflo(cc.y) * bflo(cx.y); Z_[3] = bfhi(cc.y) * bfhi(cx.y); \
                            Z_[4] = bflo(cc.z) * bflo(cx.z); Z_[5] = bfhi(cc.z) * bfhi(cx.z); Z_[6] = bflo(cc.w) * bflo(cx.w); Z_[7] = bfhi(cc.w) * bfhi(cx.w); } while (0)
                        float zp[8], zc[8], zn[8];
                        ZROW(zp, 0); ZROW(zc, 1);
#pragma unroll
                        for (int tt = 0; tt < 8; ++tt) {
                            ZROW(zn, tt + 2);
                            const u32x4 cb = cbv[tt];
                            const float bb[8] = {bflo(cb.x), bfhi(cb.x), bflo(cb.y), bfhi(cb.y), bflo(cb.z), bfhi(cb.z), bflo(cb.w), bfhi(cb.w)};
                            float y[8];
#pragma unroll
                            for (int j = 0; j < 8; ++j) y[j] = bb[j] * (zp[j] * w0[j] + zc[j] * w1[j] + zn[j] * w2[j]);
                            u32x4 ov; ov.x = pk2(y[0], y[1]); ov.y = pk2(y[2], y[3]); ov.z = pk2(y[4], y[5]); ov.w = pk2(y[6], y[7]);
                            *(u32x4*)(mix + (size_t)(t0 + tt) * D + 512 + c8) = ov;
#pragma unroll
                            for (int j = 0; j < 8; ++j) { zp[j] = zc[j]; zc[j] = zn[j]; }
                        }
#undef ZROW
                    }
                    LAS unsigned char* Vg = lds;
                    {
                        const int t16 = lane & 15, kq = lane >> 4, tt = wave * 16 + t16;
                        const bf16_t* gp = proj + (size_t)(row0 + tt) * INW + 1792 + 64 * kq;
                        u32x4 gvv[8];
#pragma unroll
                        for (int i = 0; i < 8; ++i) gvv[i] = *(const u32x4*)(gp + 8 * i);
                        float vv[64]; float sm = 0.f, sq = 0.f;
#pragma unroll
                        for (int i = 0; i < 8; ++i) {
                            const unsigned wq[4] = {gvv[i].x, gvv[i].y, gvv[i].z, gvv[i].w};
#pragma unroll
                            for (int j = 0; j < 4; ++j) { const float a0 = gelu_tanh_f(bflo(wq[j])), a1 = gelu_tanh_f(bfhi(wq[j])); vv[8 * i + 2 * j] = a0; vv[8 * i + 2 * j + 1] = a1; sm += a0 + a1; sq += a0 * a0 + a1 * a1; }
                        }
                        sm += __shfl_xor(sm, 16); sm += __shfl_xor(sm, 32); sq += __shfl_xor(sq, 16); sq += __shfl_xor(sq, 32);
                        const float mu = sm * (1.0f / 256.0f);
                        const float rs = 1.0f / sqrtf(fmaxf(sq * (1.0f / 256.0f) - mu * mu, 0.f) + LN_EPS);
#pragma unroll
                        for (int i = 0; i < 8; ++i) {
                            u32x4 w; w.x = pk2((vv[8 * i + 0] - mu) * rs, (vv[8 * i + 1] - mu) * rs); w.y = pk2((vv[8 * i + 2] - mu) * rs, (vv[8 * i + 3] - mu) * rs);
                            w.z = pk2((vv[8 * i + 4] - mu) * rs, (vv[8 * i + 5] - mu) * rs); w.w = pk2((vv[8 * i + 6] - mu) * rs, (vv[8 * i + 7] - mu) * rs);
                            *(LAS u32x4*)(Vg + tt * 528 + (64 * kq + 8 * i) * 2) = w;
                        }
                    }
                    {
                        const int gg = wave >> 1, ph = wave & 1, r32 = lane & 31, hi_ = lane >> 5;
                        const int blk = (lane >> 4) & 1, qq = (lane & 15) >> 2, pp = lane & 3;
                        const bf16_t* wsg = gmw + ((size_t)(l * 4 + gg) * 128) * 128;
                        bf16x8 bfr[8][2];
#pragma unroll
                        for (int ks = 0; ks < 8; ++ks)
#pragma unroll
                            for (int pt = 0; pt < 2; ++pt) bfr[ks][pt] = *(const bf16x8*)(wsg + (size_t)(64 * ph + 32 * pt + r32) * 128 + 16 * ks + 8 * hi_);
                        u32x2 uu[2][2][4];
#pragma unroll
                        for (int pt = 0; pt < 2; ++pt)
#pragma unroll
                            for (int ct = 0; ct < 2; ++ct)
#pragma unroll
                                for (int rg = 0; rg < 4; ++rg) uu[pt][ct][rg] = *(const u32x2*)(proj + (size_t)(row0 + 64 * ph + 32 * pt + r32) * INW + 1536 + gg * 64 + 32 * ct + 8 * rg + 4 * hi_);
                        __syncthreads();
                        f32x16 sacc[2][2];
#pragma unroll
                        for (int pt = 0; pt < 2; ++pt)
#pragma unroll
                            for (int ct = 0; ct < 2; ++ct)
#pragma unroll
                                for (int r = 0; r < 16; ++r) sacc[pt][ct][r] = 0.f;
#pragma unroll
                        for (int ks = 0; ks < 8; ++ks) {
                            bf16x8 af[2];
#pragma unroll
                            for (int ct = 0; ct < 2; ++ct) {
                                const LAS unsigned char* p0 = Vg + (16 * ks + 8 * hi_ + qq) * 528 + (gg * 64 + 32 * ct + 16 * blk + 4 * pp) * 2;
                                const s16x4 t0 = __builtin_bit_cast(s16x4, __builtin_amdgcn_ds_read_tr16_b64_v4i16((LAS s16x4*)p0));
                                const s16x4 t1 = __builtin_bit_cast(s16x4, __builtin_amdgcn_ds_read_tr16_b64_v4i16((LAS s16x4*)(p0 + 4 * 528)));
                                af[ct] = (bf16x8){t0[0], t0[1], t0[2], t0[3], t1[0], t1[1], t1[2], t1[3]};
                            }
#pragma unroll
                            for (int pt = 0; pt < 2; ++pt)
#pragma unroll
                                for (int ct = 0; ct < 2; ++ct) sacc[pt][ct] = __builtin_amdgcn_mfma_f32_32x32x16_bf16(af[ct], bfr[ks][pt], sacc[pt][ct], 0, 0, 0);
                        }
#pragma unroll
                        for (int pt = 0; pt < 2; ++pt) {
                            const int p = 64 * ph + 32 * pt + r32, row = row0 + p;
                            const float bias = kp->in[I_GMBS][(l * 4 + gg) * 128 + p];
#pragma unroll
                            for (int ct = 0; ct < 2; ++ct)
#pragma unroll
                                for (int rg = 0; rg < 4; ++rg) {
                                    const int cc = gg * 64 + 32 * ct + 8 * rg + 4 * hi_;
                                    const u32x2 u2 = uu[pt][ct][rg];
                                    const float y0 = gelu_tanh_f(bflo(u2.x)) * (sacc[pt][ct][4 * rg + 0] + bias), y1 = gelu_tanh_f(bfhi(u2.x)) * (sacc[pt][ct][4 * rg + 1] + bias);
                                    const float y2 = gelu_tanh_f(bflo(u2.y)) * (sacc[pt][ct][4 * rg + 2] + bias), y3 = gelu_tanh_f(bfhi(u2.y)) * (sacc[pt][ct][4 * rg + 3] + bias);
                                    u32x2 w; w.x = pk2(y0, y1); w.y = pk2(y2, y3);
                                    *(u32x2*)(mix + (size_t)row * D + 768 + cc) = w;
                                }
                        }
                    }
                    if (ch >= NLAT / 128) DEP_PUBLISH(cmix + cb_loc);
                    __syncthreads();
                }
            }
#undef DEP_PUBLISH
#undef DEP_ENSURE
        }
        GRID_BAR(pb + 1);

        if (IN(pb + 2)) {
            PHASE_PTRS();
            SchedPlain S; S.nM = NLAT / 256; S.nN = 4; S.nX = 0; S.xpm0 = 0; S.xpn = 0; S.G = G; S.c = bx;
            S.rowbytes = D * 2; S.Bt = (const char*)(WoutT + (size_t)l * D * D); S.btile = (size_t)256 * D * 2;
            EpiOut E{xbuf, mod_l, (float*)(ws + WS_PSTAT)};
            pg8::gemm_phase<EpiOut, SchedPlain, false>(lds, (const char*)mix, D * 2, S, E);
        }
        GRID_BAR(pb + 2);

        if (IN(pb + 3)) {
            PHASE_PTRS();
            const int RB = lastl ? 128 : 136;
            LAS int* lcnt = (LAS int*)(lds + L_N1);
            LAS int* lbase = lcnt + 32;
            LAS int* rec = lbase + 32;
            const int r16 = lane & 15, kq = lane >> 4;
            for (int blk = bx; blk < nrow_l / RB; blk += G) {
                const int rbase = blk * RB;
                {
                    const unsigned char* wimg = ws + WS_WRIMG + (size_t)l * WRIMG_BYTES;
                    constexpr int NCH_ = WRIMG_BYTES / 1024;
#pragma unroll 1
                    for (int ci = wave; ci < NCH_; ci += 8)
                        __builtin_amdgcn_global_load_lds((const unsigned*)(wimg + (size_t)ci * 1024 + lane * 16), (LAS unsigned*)(lds + ci * 1024), 16, 0, 0);
                    if (tid < (WRIMG_BYTES - NCH_ * 1024) / 16) ((LAS u32x4*)(lds + NCH_ * 1024))[tid] = ((const u32x4*)(wimg + NCH_ * 1024))[tid];
                    asm volatile("s_waitcnt vmcnt(0)" ::: "memory");
                }
                if (tid < 32) lcnt[tid] = 0;
                __syncthreads();
                f32x4 lacc[2][3];
#pragma unroll
                for (int gi = 0; gi < 2; ++gi) {
#pragma unroll
                    for (int ob = 0; ob < 3; ++ob) lacc[gi][ob] = (f32x4){0.f, 0.f, 0.f, 0.f};
                    if (gi == 0 || RB > 128) {
                        const int row = (gi == 0) ? (rbase + 16 * wave + r16) : (rbase + 128 + (r16 & 7));
                        const bool wr_ok = (gi == 0) || (r16 < 8);
                        const int ks0 = (gi == 0) ? 0 : 4 * wave, ks1 = (gi == 0) ? 32 : 4 * wave + 4;
                        const bf16_t* xr = xbuf + (size_t)row * D + 8 * kq;
                        float s = 0.f, q = 0.f;
                        {
                            const f32x4* ps = (const f32x4*)((const float*)(ws + WS_PSTAT) + ((size_t)row * 32 + 8 * kq) * 2);
#pragma unroll
                            for (int j = 0; j < 4; ++j) { const f32x4 p = ps[j]; s += p[0] + p[2]; q += p[1] + p[3]; }
                        }
                        s += __shfl_xor(s, 16); s += __shfl_xor(s, 32); q += __shfl_xor(q, 16); q += __shfl_xor(q, 32);
                        const float mean = s * (1.0f / D);
                        const float var = fmaxf(q * (1.0f / D) - mean * mean, 0.f);
                        const float rstd = 1.0f / sqrtf(var + LN_EPS);
                        if (kq == 0 && wr_ok && (gi == 0 || wave == 0)) *(f32x2*)((float*)(ws + WS_RSTAT) + (size_t)row * 2) = (f32x2){mean, rstd};
                        const float* gcv = (const float*)(ws + WS_GC) + ((size_t)(l * 9 + ((row < NLAT) ? (row / SEQ) : 8)) * 2) * D + 8 * kq;
                        unsigned char* hrow = (unsigned char*)hx + (size_t)row * D + 8 * kq;
                        const LAS unsigned char* wb[3];
#pragma unroll
                        for (int ob = 0; ob < 3; ++ob) { const int oc = (16 * ob + r16 < 36) ? (16 * ob + r16) : 35; wb[ob] = lds + oc * WR_RS + 16 * kq; }
#pragma unroll 1
                        for (int ks4 = ks0; ks4 < ks1; ks4 += 4) {
                            u32x4 xw4[4]; f32x4 gg4[4][2], cc4[4][2];
#pragma unroll
                            for (int u = 0; u < 4; ++u) { const int c = 32 * (ks4 + u); xw4[u] = *(const u32x4*)(xr + c);
#pragma unroll
                                for (int e = 0; e < 2; ++e) { gg4[u][e] = *(const f32x4*)(gcv + c + 4 * e); cc4[u][e] = *(const f32x4*)(gcv + D + c + 4 * e); } }
#pragma unroll
                            for (int u = 0; u < 4; ++u) {
                                const int ks = ks4 + u, c = 32 * ks;
                                f32x4 hh[2];
                                const u32x4 xw = xw4[u];
#pragma unroll
                                for (int e = 0; e < 2; ++e) {
                                    const unsigned w0 = e ? xw.z : xw.x, w1 = e ? xw.w : xw.y;
                                    const f32x4 v = (f32x4){bflo(w0), bfhi(w0), bflo(w1), bfhi(w1)};
                                    hh[e] = (v - mean) * rstd * gg4[u][e] + cc4[u][e];
                                }
                                u32x4 hw, lw;
                                hw.x = pk2(hh[0][0], hh[0][1]); hw.y = pk2(hh[0][2], hh[0][3]); hw.z = pk2(hh[1][0], hh[1][1]); hw.w = pk2(hh[1][2], hh[1][3]);
                                lw.x = pk2(hh[0][0] - bflo(hw.x), hh[0][1] - bfhi(hw.x)); lw.y = pk2(hh[0][2] - bflo(hw.y), hh[0][3] - bfhi(hw.y));
                                lw.z = pk2(hh[1][0] - bflo(hw.z), hh[1][1] - bfhi(hw.z)); lw.w = pk2(hh[1][2] - bflo(hw.w), hh[1][3] - bfhi(hw.w));
                                if (wr_ok) { u32x2 h8; h8.x = pk4_fp8(hh[0][0], hh[0][1], hh[0][2], hh[0][3]); h8.y = pk4_fp8(hh[1][0], hh[1][1], hh[1][2], hh[1][3]); *(u32x2*)(hrow + c) = h8; }
                                const bf16x8 ahi = __builtin_bit_cast(bf16x8, hw), alo = __builtin_bit_cast(bf16x8, lw);
#pragma unroll
                                for (int ob = 0; ob < 3; ++ob) {
                                    const bf16x8 bh = *(const LAS bf16x8*)(wb[ob] + 64 * ks), bl = *(const LAS bf16x8*)(wb[ob] + WR_LO + 64 * ks);
                                    lacc[gi][ob] = __builtin_amdgcn_mfma_f32_16x16x32_bf16(ahi, bh, lacc[gi][ob], 0, 0, 0);
                                    lacc[gi][ob] = __builtin_amdgcn_mfma_f32_16x16x32_bf16(alo, bh, lacc[gi][ob], 0, 0, 0);
                                    lacc[gi][ob] = __builtin_amdgcn_mfma_f32_16x16x32_bf16(ahi, bl, lacc[gi][ob], 0, 0, 0);
                                }
                            }
                        }
                    }
                }
                PROBE_MARK(17 + l);
                __syncthreads();
                LAS float* lgt = (LAS float*)(lds + wave * 2368);
                LAS float* part = (LAS float*)(lds + 18944 + wave * 2368);
                LAS float* lgx = (LAS float*)(lds + 37888);
#pragma unroll
                for (int ob = 0; ob < 3; ++ob)
#pragma unroll
                    for (int i = 0; i < 4; ++i) { const int col = 16 * ob + r16; if (col < 36) { lgt[(4 * kq + i) * 37 + col] = lacc[0][ob][i]; part[(4 * kq + i) * 37 + col] = lacc[1][ob][i]; } }
                __syncthreads();
                if (RB > 128 && tid < 8 * 36) { const int rr = tid / 36, col = tid % 36; float a = 0.f;
#pragma unroll
                    for (int w = 0; w < 8; ++w) a += ((LAS float*)(lds + 18944 + w * 2368))[rr * 37 + col];
                    lgx[rr * 37 + col] = a; }
                __syncthreads();
#pragma unroll 1
                for (int gi = 0; gi < 2; ++gi) {
                    const bool act = (gi == 0) ? (lane < 16) : (RB > 128 && wave == 0 && lane < 8);
                    if (act) {
                        const int row = (gi == 0) ? (rbase + 16 * wave + lane) : (rbase + 128 + lane);
                        const LAS float* lr = (gi == 0) ? (lgt + lane * 37) : (lgx + lane * 37);
                        float gl[4];
#pragma unroll
                        for (int j = 0; j < 4; ++j) gl[j] = lr[j] + kp->in[I_BRG][l * 4 + j];
                        int gsel = 0; float gm = gl[0];
#pragma unroll
                        for (int j = 1; j < 4; ++j) if (gl[j] > gm) { gm = gl[j]; gsel = j; }
                        float gsum = 0.f;
#pragma unroll
                        for (int j = 0; j < 4; ++j) gsum += expf(gl[j] - gm);
                        const float pgrp = 1.0f / gsum;
                        float el[8];
#pragma unroll
                        for (int j = 0; j < 8; ++j) el[j] = lr[4 + 8 * gsel + j] + kp->in[I_BRE][l * 32 + gsel * 8 + j];
                        int i1 = 0; float e1 = el[0];
#pragma unroll
                        for (int j = 1; j < 8; ++j) if (el[j] > e1) { e1 = el[j]; i1 = j; }
                        int i2 = -1; float e2 = -INFINITY;
#pragma unroll
                        for (int j = 0; j < 8; ++j) if (j != i1 && el[j] > e2) { e2 = el[j]; i2 = j; }
                        const float ex = expf(e2 - e1);
                        const float ga = pgrp / (1.0f + ex), gb = pgrp * ex / (1.0f + ex);
                        const int ea = gsel * 8 + i1, eb = gsel * 8 + i2;
                        const int ra = __hip_atomic_fetch_add(&lcnt[ea], 1, __ATOMIC_RELAXED, __HIP_MEMORY_SCOPE_WORKGROUP);
                        const int rb2 = __hip_atomic_fetch_add(&lcnt[eb], 1, __ATOMIC_RELAXED, __HIP_MEMORY_SCOPE_WORKGROUP);
                        LAS int* rc = rec + ((wave * 2 + gi) * 16 + lane) * 4;
                        rc[0] = ea; rc[1] = ra; rc[2] = eb; rc[3] = rb2;
                        *(f32x2*)(gates + (size_t)row * 2) = (f32x2){ga, gb};
                    }
                }
                __syncthreads();
                if (tid < 32) lbase[tid] = (int)__hip_atomic_fetch_add(cnt_l + tid, (unsigned)lcnt[tid], __ATOMIC_RELAXED, __HIP_MEMORY_SCOPE_AGENT);
                __syncthreads();
#pragma unroll 1
                for (int gi = 0; gi < 2; ++gi) {
                    const bool act = (gi == 0) ? (lane < 16) : (RB > 128 && wave == 0 && lane < 8);
                    if (act) {
                        const int row = (gi == 0) ? (rbase + 16 * wave + lane) : (rbase + 128 + lane);
                        const LAS int* rc = rec + ((wave * 2 + gi) * 16 + lane) * 4;
                        const int ea = rc[0], ra = lbase[ea] + rc[1], eb = rc[2], rb2 = lbase[eb] + rc[3];
                        elist[(size_t)ea * NROW + ra] = row; elist[(size_t)eb * NROW + rb2] = row;
                        *(int4*)(tokinfo + (size_t)row * 4) = make_int4(ea, ra, eb, rb2);
                    }
                }
                __syncthreads();
            }
        }
        GRID_BAR(pb + 3);

        LAS int* tile_e = (LAS int*)(lds + L_TILE_E); LAS int* tile_r0 = (LAS int*)(lds + L_TILE_R0); LAS int* tile_j = (LAS int*)(lds + L_TILE_J);
        LAS int* pstart = (LAS int*)(lds + L_PSTART); LAS int* ecnt = (LAS int*)(lds + L_CNT); LAS int* ntile_p = (LAS int*)(lds + L_NT);
        if (IN(pb + 4) || IN(pb + 5) || IN(pb + 6)) {
            PHASE_PTRS();
            __syncthreads();
            if (tid < 64) {
                const int e = tid & 31;
                const int c = (int)__hip_atomic_load(cnt_l + e, __ATOMIC_RELAXED, __HIP_MEMORY_SCOPE_AGENT);
                const int nt_ = (c + 255) >> 8;
                int inc = nt_;
#pragma unroll
                for (int o = 1; o < 32; o <<= 1) { const int v = __shfl_up(inc, o, 32); if (e >= o) inc += v; }
                const int tb = inc - nt_;
                if (tid < 32) {
                    ecnt[e] = c; pstart[e] = tb * 256;
#pragma nounroll
                    for (int j = 0; j < nt_; ++j) { tile_e[tb + j] = e; tile_r0[tb + j] = (tb + j) * 256; tile_j[tb + j] = j; }
                    if (e == 31) ntile_p[0] = inc;
                }
            }
            __syncthreads();
        }

        if (IN(pb + 4)) {
            PHASE_PTRS();
            const int ntile = __builtin_amdgcn_readfirstlane(ntile_p[0]);
            LAS int* idx = (LAS int*)(lds + L_IDX);
            {
                int tok_[8];
#pragma unroll
                for (int i = 0; i < 8; ++i) {
                    const int L = i * G + bx; tok_[i] = 0;
                    if (L < 4 * ntile && tid < 256) { const int t = L >> 2, e = tile_e[t], j = tile_j[t], ce = ecnt[e]; const int rr = j * 256 + tid; tok_[i] = elist[(size_t)e * NROW + (rr < ce ? rr : 0)]; }
                }
#pragma unroll
                for (int i = 0; i < 8; ++i) { const int L = i * G + bx; if (L < 4 * ntile && tid < 256) idx[i * 256 + tid] = tok_[i] * D; }
            }
            __syncthreads();
            SchedMoe<true> S; S.ntile = ntile; S.G = G; S.c = bx; S.rowbytes = D; S.Bt = (const char*)W13T; S.btile = (size_t)256 * D; S.bexp = (size_t)1024 * D;
            S.tile_e = tile_e; S.tile_r0 = tile_r0; S.idx = idx;
            EpiH E{(unsigned char*)Hb};
            pg8::gemm_phase<EpiH, SchedMoe<true>, true>(lds, (const char*)hx, D, S, E);
        }
        GRID_BAR(pb + 4);

        if (IN(pb + 5)) {
            PHASE_PTRS();
            const int ntile = __builtin_amdgcn_readfirstlane(ntile_p[0]);
            SchedMoe<false> S; S.ntile = ntile; S.G = G; S.c = bx; S.rowbytes = DE; S.Bt = (const char*)W2T; S.btile = (size_t)256 * DE; S.bexp = (size_t)1024 * DE;
            S.tile_e = tile_e; S.tile_r0 = tile_r0; S.idx = nullptr;
            EpiY E{(unsigned char*)Yb};
            pg8::gemm_phase<EpiY, SchedMoe<false>, true>(lds, (const char*)Hb, DE, S, E);
        }
        GRID_BAR(pb + 5);

        if (IN(pb + 6)) {
            PHASE_PTRS();
            LAS float* Lg1 = (LAS float*)lds; LAS float* Lb1 = Lg1 + D; LAS float* Lg2 = Lb1 + D; LAS float* Lb2 = Lg2 + D;
            LAS float* Lgm = Lb2 + D; LAS float* Lshn = Lgm + 9 * D; LAS float* Lscn = Lshn + 9 * D;
            {
                const float* mod_n = modall + (size_t)(l + 1) * 9 * 6144;
                const int nch = 16 + 36 + (lastl ? 0 : 72);
#pragma unroll 1
                for (int ci = wave; ci < nch; ci += 8) {
                    const float* src; LAS float* dst;
                    if (ci < 16) { const int v = ci >> 2, qd = ci & 3; src = kp->in[v == 0 ? I_LN1G : (v == 1 ? I_LN1B : (v == 2 ? I_LN2G : I_LN2B))] + l * D + 256 * qd; dst = Lg1 + v * D + 256 * qd; }
                    else { const int r_ = ci - 16, arr = r_ / 36, rr = (r_ % 36) >> 2, qd = r_ & 3;
                        src = ((arr == 0) ? (mod_l + 5 * D) : (arr == 1 ? mod_n : mod_n + D)) + (size_t)rr * 6144 + 256 * qd; dst = ((arr == 0) ? Lgm : (arr == 1 ? Lshn : Lscn)) + rr * D + 256 * qd; }
                    __builtin_amdgcn_global_load_lds((const unsigned*)(src + 4 * lane), (LAS unsigned*)dst, 16, 0, 0);
                }
                asm volatile("s_waitcnt vmcnt(0)" ::: "memory");
            }
            __syncthreads();
            const float* rstat = (const float*)(ws + WS_RSTAT);
            int4 tiN[2]; f32x2 gtN[2], rsN[2];
#pragma unroll
            for (int e = 0; e < 2; ++e) { int rw = gw + e * NGW; rw = rw < nrow_l ? rw : gw; tiN[e] = *(const int4*)(tokinfo + (size_t)rw * 4); gtN[e] = *(const f32x2*)(gates + (size_t)rw * 2); rsN[e] = *(const f32x2*)(rstat + (size_t)rw * 2); }
            for (int rowA = gw; rowA < nrow_l; rowA += 2 * NGW) {
                int4 ti[2]; f32x2 gt[2], rs1[2]; int rows[2]; bool valid[2];
#pragma unroll
                for (int e = 0; e < 2; ++e) { ti[e] = tiN[e]; gt[e] = gtN[e]; rs1[e] = rsN[e]; rows[e] = rowA + e * NGW; valid[e] = rows[e] < nrow_l; if (!valid[e]) rows[e] = rowA; }
                u32x2 xv[2][4]; unsigned ya[2][4], yb[2][4];
#pragma unroll
                for (int e = 0; e < 2; ++e) {
                    const bf16_t* xr = xbuf + (size_t)rows[e] * D + 4 * lane;
                    const unsigned char* pa = (const unsigned char*)Yb + (size_t)(pstart[ti[e].x] + ti[e].y) * D + 4 * lane; const unsigned char* pb2 = (const unsigned char*)Yb + (size_t)(pstart[ti[e].z] + ti[e].w) * D + 4 * lane;
#pragma unroll
                    for (int j = 0; j < 4; ++j) { xv[e][j] = *(const u32x2*)(xr + 256 * j); ya[e][j] = *(const unsigned*)(pa + 256 * j); yb[e][j] = *(const unsigned*)(pb2 + 256 * j); }
                }
#pragma unroll
                for (int e = 0; e < 2; ++e) { int rw = rowA + (2 + e) * NGW; rw = rw < nrow_l ? rw : rowA; tiN[e] = *(const int4*)(tokinfo + (size_t)rw * 4); gtN[e] = *(const f32x2*)(gates + (size_t)rw * 2); rsN[e] = *(const f32x2*)(rstat + (size_t)rw * 2); }
#pragma unroll
                for (int e = 0; e < 2; ++e) {
                    const int row = rows[e];
                    const int mr = (row < NLAT) ? (row / SEQ) : 8;
                    f32x4 v[4]; float s = 0.f;
#pragma unroll
                    for (int j = 0; j < 4; ++j) {
                        const int c = 256 * j + 4 * lane;
                        const f32x4 xf = (f32x4){bflo(xv[e][j].x), bfhi(xv[e][j].x), bflo(xv[e][j].y), bfhi(xv[e][j].y)};
                        const f32x4 x1 = (xf - rs1[e][0]) * rs1[e][1] * *(const LAS f32x4*)(Lg1 + c) + *(const LAS f32x4*)(Lb1 + c), g2 = *(const LAS f32x4*)(Lgm + mr * D + c);
                        const int a = (int)ya[e][j], b = (int)yb[e][j]; const float ga = gt[e][0] * (1.0f / Y8_SCALE), gb = gt[e][1] * (1.0f / Y8_SCALE);
                        f32x4 y; y[0] = ga * __builtin_amdgcn_cvt_f32_fp8(a, 0) + gb * __builtin_amdgcn_cvt_f32_fp8(b, 0); y[1] = ga * __builtin_amdgcn_cvt_f32_fp8(a, 1) + gb * __builtin_amdgcn_cvt_f32_fp8(b, 1);
                        y[2] = ga * __builtin_amdgcn_cvt_f32_fp8(a, 2) + gb * __builtin_amdgcn_cvt_f32_fp8(b, 2); y[3] = ga * __builtin_amdgcn_cvt_f32_fp8(a, 3) + gb * __builtin_amdgcn_cvt_f32_fp8(b, 3);
                        v[j] = ALPHA * x1 + g2 * y;
                        s += (v[j][0] + v[j][1]) + (v[j][2] + v[j][3]);
                    }
                    const float mean = wave_sum(s) * (1.0f / D); float s2 = 0.f;
#pragma unroll
                    for (int j = 0; j < 4; ++j) { v[j] = v[j] - mean; s2 += (v[j][0] * v[j][0] + v[j][1] * v[j][1]) + (v[j][2] * v[j][2] + v[j][3] * v[j][3]); }
                    const float rstd = 1.0f / sqrtf(wave_sum(s2) * (1.0f / D) + LN_EPS);
                    if (valid[e]) {
#pragma unroll
                        for (int j = 0; j < 4; ++j) {
                            const int c = 256 * j + 4 * lane;
                            const f32x4 x2 = v[j] * rstd * *(const LAS f32x4*)(Lg2 + c) + *(const LAS f32x4*)(Lb2 + c);
                            if (lastl) *(f32x4*)(kp->out + (size_t)row * D + c) = x2;
                            if (!lastl) {
                                u32x2 wx; wx.x = pk2(x2[0], x2[1]); wx.y = pk2(x2[2], x2[3]); *(u32x2*)(xbuf + (size_t)row * D + c) = wx;
                                const f32x4 hn = x2 * (1.0f + *(const LAS f32x4*)(Lscn + mr * D + c)) + *(const LAS f32x4*)(Lshn + mr * D + c);
                                u32x2 w; w.x = pk2(hn[0], hn[1]); w.y = pk2(hn[2], hn[3]);
                                *(u32x2*)(hx + (size_t)row * D + c) = w;
                            }
                        }
                    }
                }
            }
        }
        if (!lastl) GRID_BAR(pb + 6); else PROBE_MARK(pb + 6);
    }
#if defined(PROBE_A)
    if (blockIdx.x == 0) { const unsigned long long tgt = pr_a + (pr_b / 2000ull) * 400000ull    , t0_ = __builtin_amdgcn_s_memrealtime();
        while (__builtin_amdgcn_s_memrealtime() - t0_ < tgt) __builtin_amdgcn_s_sleep(64); }
#endif
#undef IN
#undef GRID_BAR
}

extern "C" void kernel_launch(void* const* d_in, const int* in_sizes, int n_in, void* d_out, int out_size, void* d_ws, size_t ws_size, hipStream_t stream) {
    static int grid = 0;
    if (grid == 0) {
        if (n_in != 23 || out_size != NLAT * D || ws_size < WS_END) { fprintf(stderr, "kernel_launch: unexpected shapes (n_in %d out %d ws %zu)\n", n_in, out_size, ws_size); grid = -1; return; }
        int dev = 0, cus = 0, per_cu = 0;
        if (hipGetDevice(&dev) != hipSuccess || hipDeviceGetAttribute(&cus, hipDeviceAttributeMultiprocessorCount, dev) != hipSuccess) { grid = -1; return; }
        if (hipFuncSetAttribute((const void*)fwd_kernel, hipFuncAttributeMaxDynamicSharedMemorySize, LDS_BYTES) != hipSuccess) { fprintf(stderr, "kernel_launch: hipFuncSetAttribute failed\n"); grid = -1; return; }
        if (hipOccupancyMaxActiveBlocksPerMultiprocessor(&per_cu, (const void*)fwd_kernel, 512, LDS_BYTES) != hipSuccess || per_cu < 1) { fprintf(stderr, "kernel_launch: occupancy query says %d\n", per_cu); }
        (void)hipGetLastError();
        grid = cus;
    }
    if (grid < 0) return;
    if (hipMemsetAsync((char*)d_ws + WS_CTL, 0, CTL_ZERO_BYTES, stream) != hipSuccess) return;
    Args a{};
    for (int i = 0; i < 23; ++i) a.in[i] = (const float*)d_in[i];
    a.out = (float*)d_out; a.ws = (unsigned char*)d_ws;
#if MK_N_LAUNCHES == 1
    a.ph_lo = 0; a.ph_hi = NPH;
    hipLaunchKernelGGL(fwd_kernel, dim3(grid), dim3(512), LDS_BYTES, stream, a);
#else
    for (int p = 0; p < NPH; ++p) { a.ph_lo = p; a.ph_hi = p + 1; hipLaunchKernelGGL(fwd_kernel, dim3(grid), dim3(512), LDS_BYTES, stream, a); }
#endif
}
```
